# Optimizing an MI355X kernel written in HIP

```python
import jax, jax.numpy as jnp
from jax import lax
import numpy as np

D_MODEL = 1024
BATCH = 4
SEQ = 8192
DEPTH = 2

GRID_W = 64
CTX_LEN = 256
A_HEADS = 8
A_KV_HEADS = 2
A_HEAD_DIM = 64
WINDOW = 128
A_BLOCK = 128
ROPE_BASE = 10000.0
G_HEADS = 4
G_DK = 64
G_DV = 128
G_RANK = 16
G_TAU = 16.0
M_HEADS = 4
M_HEAD_DIM = 128
M_CONV = 5
CHUNK = 64
D_FF = 2816
N_MOD = 9
EPS = 1e-6

A_Q = A_HEADS * A_HEAD_DIM
A_KV = A_KV_HEADS * A_HEAD_DIM
G_QK = G_HEADS * G_DK
G_V = G_HEADS * G_DV
M_W = M_HEADS * M_HEAD_DIM
IN_SPLITS = (A_Q, A_KV, A_KV,
             G_QK, G_QK, G_V, G_V, 2 * G_RANK,
             M_W, M_W, M_W, M_W, 2 * M_HEADS, 2 * M_HEADS,
             D_MODEL, D_MODEL, D_MODEL)
D_IN = sum(IN_SPLITS)

kernel_name = 'hybrid_diffusion_gated_parallel_mixers'

F32 = jnp.float32


def rmsnorm(x, g):
    xf = x.astype(F32)
    y = xf * lax.rsqrt(jnp.mean(xf * xf, axis=-1, keepdims=True) + EPS)
    return (y * g.astype(F32)).astype(x.dtype)


def swiglu(h, w13, w2):
    a, b = jnp.split(h @ w13, 2, axis=-1)
    return (jax.nn.silu(a) * b) @ w2


def split_cols(z):
    idx = [int(i) for i in np.cumsum(IN_SPLITS)[:-1]]
    return jnp.split(z, idx, axis=-1)


def dwconv_centred(x, w, b):
    pad = w.shape[0] // 2
    y = lax.conv_general_dilated(x, w[:, None, :].astype(x.dtype), (1,), [(pad, pad)],
                                 dimension_numbers=('NWC', 'WIO', 'NWC'),
                                 feature_group_count=x.shape[-1])
    return y + b.astype(x.dtype)


def axial_rope(rows):
    r = jnp.repeat(jnp.arange(rows), GRID_W).astype(F32)
    col = jnp.tile(jnp.arange(GRID_W), rows).astype(F32)
    n_freq = A_HEAD_DIM // 4
    inv = ROPE_BASE ** (-jnp.arange(n_freq, dtype=F32) / n_freq)
    ang = jnp.concatenate([r[:, None] * inv, col[:, None] * inv], axis=-1)
    return jnp.cos(ang), jnp.sin(ang)


def apply_rope(x, cos, sin):
    x1, x2 = jnp.split(x.astype(F32), 2, axis=-1)
    c, s = cos[:, None, :], sin[:, None, :]
    return jnp.concatenate([x1 * c - x2 * s, x1 * s + x2 * c], axis=-1).astype(x.dtype)


def softmax_with_sink(logits, sink):
    full = jnp.concatenate([logits, jnp.broadcast_to(sink, logits.shape[:-1] + (1,))], axis=-1)
    return jax.nn.softmax(full, axis=-1)[..., :-1]


def latent_window_attention(q, k, v, k_ctx, v_ctx, sink):
    B, S, H, hd = q.shape
    G = H // A_KV_HEADS
    nb = S // A_BLOCK
    scale = hd ** -0.5
    qb = q.reshape(B, nb, A_BLOCK, A_KV_HEADS, G, hd)

    def band(a):
        ap = jnp.pad(a, ((0, 0), (A_BLOCK, A_BLOCK), (0, 0), (0, 0)))
        ap = ap.reshape(B, nb + 2, A_BLOCK, A_KV_HEADS, hd)
        return jnp.concatenate([ap[:, :-2], ap[:, 1:-1], ap[:, 2:]], axis=2)

    kb, vb = band(k), band(v)
    s_loc = jnp.einsum('bnqhgd,bnkhd->bnhgqk', qb, kb).astype(F32) * scale
    s_ctx = jnp.einsum('bnqhgd,bchd->bnhgqc', qb, k_ctx).astype(F32) * scale
    qpos = jnp.arange(S).reshape(nb, A_BLOCK)
    kpos = (jnp.arange(nb)[:, None] - 1) * A_BLOCK + jnp.arange(3 * A_BLOCK)[None, :]
    valid = ((jnp.abs(qpos[:, :, None] - kpos[:, None, :]) <= WINDOW)
             & (kpos[:, None, :] >= 0) & (kpos[:, None, :] < S))
    s_loc = jnp.where(valid[None, :, None, None], s_loc, -jnp.inf)
    sink_b = sink.astype(F32).reshape(1, 1, A_KV_HEADS, G, 1, 1)
    p = softmax_with_sink(jnp.concatenate([s_loc, s_ctx], axis=-1), sink_b)
    p_loc = p[..., :3 * A_BLOCK].astype(v.dtype)
    p_ctx = p[..., 3 * A_BLOCK:].astype(v.dtype)
    o = (jnp.einsum('bnhgqk,bnkhd->bnqhgd', p_loc, vb)
         + jnp.einsum('bnhgqc,bchd->bnqhgd', p_ctx, v_ctx))
    return o.reshape(B, S, H * hd)


def context_attention(q, k, v, sink):
    B, L, H, hd = q.shape
    G = H // A_KV_HEADS
    qg = q.reshape(B, L, A_KV_HEADS, G, hd)
    s = jnp.einsum('bqhgd,bkhd->bhgqk', qg, k).astype(F32) * hd ** -0.5
    p = softmax_with_sink(s, sink.astype(F32).reshape(1, A_KV_HEADS, G, 1, 1)).astype(v.dtype)
    return jnp.einsum('bhgqk,bkhd->bqhgd', p, v).reshape(B, L, H * hd)


def to_chunks(a):
    B, T, H, d = a.shape
    return a.reshape(B, T // CHUNK, CHUNK, H, d).transpose(1, 0, 3, 2, 4)


def from_chunks(a):
    n, B, H, L, d = a.shape
    return a.transpose(1, 0, 3, 2, 4).reshape(B, n * L, H, d)


def gla_scan(q, k, v, log_a, state):
    tri = jnp.tril(jnp.ones((CHUNK, CHUNK), dtype=bool))

    def step(S, inp):
        qc, kc, vc, ac = inp
        b = jnp.cumsum(ac, axis=2)
        diff = b[:, :, :, None, :] - b[:, :, None, :, :]
        dec = jnp.where(tri[:, :, None], jnp.exp(jnp.where(tri[:, :, None], diff, 0.0)), 0.0)
        att = jnp.einsum('bhid,bhjd,bhijd->bhij', qc, kc, dec)
        o = (jnp.einsum('bhid,bhde->bhie', qc * jnp.exp(b), S)
             + jnp.einsum('bhij,bhje->bhie', att, vc))
        b_last = b[:, :, -1:, :]
        S = (jnp.exp(b_last[:, :, 0, :])[..., None] * S
             + jnp.einsum('bhjd,bhje->bhde', kc * jnp.exp(b_last - b), vc))
        return S, o

    xs = tuple(to_chunks(a.astype(F32)) for a in (q, k, v, log_a))
    S, o = lax.scan(step, state, xs)
    return S, from_chunks(o)


def mlstm_scan(q, k, v, i_pre, log_f, carry):
    tri = jnp.tril(jnp.ones((CHUNK, CHUNK), dtype=bool))

    def step(carry, inp):
        C, n, m = carry
        qc, kc, vc, ic, fc = inp
        ic, fc = ic[..., 0], fc[..., 0]
        b = jnp.cumsum(fc, axis=-1)
        log_w = jnp.where(tri, b[..., :, None] - b[..., None, :] + ic[..., None, :], -jnp.inf)
        log_inter = b + m[..., None]
        m_i = jnp.maximum(log_inter, jnp.max(log_w, axis=-1))
        w = jnp.exp(log_w - m_i[..., None])
        w_inter = jnp.exp(log_inter - m_i)
        s = jnp.einsum('bhid,bhjd->bhij', qc, kc) * w
        num = (w_inter[..., None] * jnp.einsum('bhid,bhde->bhie', qc, C)
               + jnp.einsum('bhij,bhje->bhie', s, vc))
        den = w_inter * jnp.einsum('bhid,bhd->bhi', qc, n) + jnp.sum(s, axis=-1)
        h = num / jnp.maximum(jnp.abs(den), jnp.exp(-m_i))[..., None]
        m_new = m_i[..., -1]
        w_state = jnp.exp(b[..., -1:] - b + ic - m_new[..., None])
        decay = jnp.exp(b[..., -1] + m - m_new)
        C = decay[..., None, None] * C + jnp.einsum('bhj,bhjd,bhje->bhde', w_state, kc, vc)
        n = decay[..., None] * n + jnp.einsum('bhj,bhjd->bhd', w_state, kc)
        return (C, n, m_new), h

    xs = tuple(to_chunks(a.astype(F32)) for a in (q, k, v, i_pre, log_f))
    carry, h = lax.scan(step, carry, xs)
    return carry, from_chunks(h)


def flip_time(a, rev):
    return a[:, ::-1] if rev else a


def bidirectional(scan_fn, init, ctx_dirs, lat_dirs):
    out_ctx, out_lat = [], []
    for d in range(2):
        rev = d == 1
        state, o_c = scan_fn(*(flip_time(a, rev) for a in ctx_dirs[d]), init)
        _, o_l = scan_fn(*(flip_time(a, rev) for a in lat_dirs[d]), state)
        out_ctx.append(flip_time(o_c, rev))
        out_lat.append(flip_time(o_l, rev))
    return out_ctx[0] + out_ctx[1], out_lat[0] + out_lat[1]


def stream_features(h, lp):
    B, T, _ = h.shape
    (aq, ak, av, gq, gk, gv, gr, gg, mq, mk, mv, mo, mi, mf, s_a, s_g, s_m) = split_cols(h @ lp['w_in'])
    f = {}
    f['aq'] = rmsnorm(aq.reshape(B, T, A_HEADS, A_HEAD_DIM), lp['attn_q_norm'])
    f['ak'] = rmsnorm(ak.reshape(B, T, A_KV_HEADS, A_HEAD_DIM), lp['attn_k_norm'])
    f['av'] = av.reshape(B, T, A_KV_HEADS, A_HEAD_DIM)
    f['gq'] = gq.reshape(B, T, G_HEADS, G_DK) * (G_DK ** -0.5)
    f['gk'] = gk.reshape(B, T, G_HEADS, G_DK)
    f['gv'] = gv.reshape(B, T, G_HEADS, G_DV)
    f['gr'] = gr
    gate_lr = gg.reshape(B, T, 2, G_RANK)
    log_a = jax.nn.log_sigmoid(
        (jnp.einsum('btnr,nrk->btnk', gate_lr, lp['gla_w2']) + lp['gla_b']).astype(F32)) / G_TAU
    f['ga'] = tuple(log_a[:, :, d].reshape(B, T, G_HEADS, G_DK) for d in range(2))
    mqk = jax.nn.silu(dwconv_centred(jnp.concatenate([mq, mk], axis=-1),
                                     lp['mlstm_conv_w'], lp['mlstm_conv_b']))
    mq, mk = jnp.split(mqk, 2, axis=-1)
    f['mq'] = mq.reshape(B, T, M_HEADS, M_HEAD_DIM)
    f['mk'] = mk.reshape(B, T, M_HEADS, M_HEAD_DIM) * (M_HEAD_DIM ** -0.5)
    f['mv'] = mv.reshape(B, T, M_HEADS, M_HEAD_DIM)
    f['mo'] = mo
    i_pre = (mi.reshape(B, T, 2, M_HEADS) + lp['mlstm_ib']).astype(F32)
    log_f = jax.nn.log_sigmoid((mf.reshape(B, T, 2, M_HEADS) + lp['mlstm_fb']).astype(F32))
    f['mi'] = tuple(i_pre[:, :, d, :, None] for d in range(2))
    f['mf'] = tuple(log_f[:, :, d, :, None] for d in range(2))
    f['branch_gates'] = (jax.nn.sigmoid(s_a), jax.nn.sigmoid(s_g), jax.nn.sigmoid(s_m))
    return f


def merge_branches(f, att, gla, mlstm, lp):
    dt = att.dtype
    B, T = att.shape[:2]
    g = rmsnorm(gla.astype(dt), lp['gla_norm']).reshape(B, T, G_V) * jax.nn.silu(f['gr'])
    m = rmsnorm(mlstm.astype(dt), lp['mlstm_norm']).reshape(B, T, M_W) * jax.nn.sigmoid(f['mo'])
    ga, gg, gm = f['branch_gates']
    y = (ga * (att @ lp['w_out_attn']) + gg * (g @ lp['w_out_gla'])
         + gm * (m @ lp['w_out_mlstm']))
    return y @ lp['w_o']


def token_mixer(xn, cn, cos, sin, lp, want_ctx):
    B = xn.shape[0]
    fl = stream_features(xn, lp)
    fc = stream_features(cn, lp)
    q_lat = apply_rope(fl['aq'], cos, sin)
    k_lat = apply_rope(fl['ak'], cos, sin)
    att_l = latent_window_attention(q_lat, k_lat, fl['av'], fc['ak'], fc['av'], lp['attn_sink'])
    g0 = jnp.zeros((B, G_HEADS, G_DK, G_DV), F32)
    gla_c, gla_l = bidirectional(
        gla_scan, g0,
        tuple((fc['gq'], fc['gk'], fc['gv'], fc['ga'][d]) for d in range(2)),
        tuple((fl['gq'], fl['gk'], fl['gv'], fl['ga'][d]) for d in range(2)))
    m0 = (jnp.zeros((B, M_HEADS, M_HEAD_DIM, M_HEAD_DIM), F32),
          jnp.zeros((B, M_HEADS, M_HEAD_DIM), F32),
          jnp.zeros((B, M_HEADS), F32))
    ml_c, ml_l = bidirectional(
        mlstm_scan, m0,
        tuple((fc['mq'], fc['mk'], fc['mv'], fc['mi'][d], fc['mf'][d]) for d in range(2)),
        tuple((fl['mq'], fl['mk'], fl['mv'], fl['mi'][d], fl['mf'][d]) for d in range(2)))
    y_lat = merge_branches(fl, att_l, gla_l, ml_l, lp)
    if not want_ctx:
        return y_lat, None
    att_c = context_attention(fc['aq'], fc['ak'], fc['av'], lp['attn_sink'])
    y_ctx = merge_branches(fc, att_c, gla_c, ml_c, lp)
    return y_lat, y_ctx


def adaln(h, m, j, gain):
    return rmsnorm(h, gain) * (1 + m[..., 3 * j + 1, :, :]) + m[..., 3 * j, :, :]


def trunk_layer(x, ctx, c, c_ctx, cos, sin, lp, last):
    B = x.shape[0]
    mod_l = (jax.nn.silu(c) @ lp['mod_w'] + lp['mod_b']).reshape(B, N_MOD, 1, D_MODEL)
    mod_c = (jax.nn.silu(c_ctx) @ lp['mod_w'] + lp['mod_b']).reshape(N_MOD, 1, D_MODEL)
    g = lp['norm_g']
    x = x + 0.5 * mod_l[:, 2] * swiglu(adaln(x, mod_l, 0, g[0]), lp['ffn1_w13'], lp['ffn1_w2'])
    ctx = ctx + 0.5 * mod_c[2] * swiglu(adaln(ctx, mod_c, 0, g[0]), lp['ffn1_w13'], lp['ffn1_w2'])
    y_l, y_c = token_mixer(adaln(x, mod_l, 1, g[1]), adaln(ctx, mod_c, 1, g[1]), cos, sin, lp, not last)
    x = x + mod_l[:, 5] * y_l
    x = x + 0.5 * mod_l[:, 8] * swiglu(adaln(x, mod_l, 2, g[2]), lp['ffn2_w13'], lp['ffn2_w2'])
    if not last:
        ctx = ctx + mod_c[5] * y_c
        ctx = ctx + 0.5 * mod_c[8] * swiglu(adaln(ctx, mod_c, 2, g[2]), lp['ffn2_w13'], lp['ffn2_w2'])
    return x, ctx


def setup_inputs(seed: int = 0) -> dict:
    key = jax.random.key(seed)
    ks = iter(jax.random.split(key, 40))

    def nrm(shape, s):
        return jax.random.normal(next(ks), shape, F32) * s

    def uni(shape):
        return jax.random.uniform(next(ks), shape, F32)

    D = D_MODEL
    return {
        'x': nrm((BATCH, SEQ, D), 1.0),
        'c': nrm((BATCH, D), 1.0),
        'ctx': nrm((BATCH, CTX_LEN, D), 1.0),
        'c_ctx': nrm((D,), 1.0),
        'mod_w': nrm((DEPTH, D, N_MOD * D), D ** -0.5),
        'mod_b': nrm((DEPTH, N_MOD * D), 0.02),
        'norm_g': 1.0 + nrm((DEPTH, 3, D), 0.02),
        'ffn1_w13': nrm((DEPTH, D, 2 * D_FF), D ** -0.5),
        'ffn1_w2': nrm((DEPTH, D_FF, D), D_FF ** -0.5),
        'ffn2_w13': nrm((DEPTH, D, 2 * D_FF), D ** -0.5),
        'ffn2_w2': nrm((DEPTH, D_FF, D), D_FF ** -0.5),
        'w_in': nrm((DEPTH, D, D_IN), D ** -0.5),
        'attn_q_norm': 1.0 + nrm((DEPTH, A_HEAD_DIM), 0.02),
        'attn_k_norm': 1.0 + nrm((DEPTH, A_HEAD_DIM), 0.02),
        'attn_sink': nrm((DEPTH, A_HEADS), 0.5),
        'gla_w2': nrm((DEPTH, 2, G_RANK, G_QK), G_RANK ** -0.5),
        'gla_b': 1.0 + nrm((DEPTH, 2, G_QK), 0.1),
        'gla_norm': 1.0 + nrm((DEPTH, G_DV), 0.02),
        'mlstm_conv_w': nrm((DEPTH, M_CONV, 2 * M_W), M_CONV ** -0.5),
        'mlstm_conv_b': nrm((DEPTH, 2 * M_W), 0.02),
        'mlstm_ib': nrm((DEPTH, 2, M_HEADS), 0.1),
        'mlstm_fb': 3.0 + 3.0 * uni((DEPTH, 2, M_HEADS)),
        'mlstm_norm': 1.0 + nrm((DEPTH, M_HEAD_DIM), 0.02),
        'w_out_attn': nrm((DEPTH, A_Q, D), A_Q ** -0.5),
        'w_out_gla': nrm((DEPTH, G_V, D), G_V ** -0.5),
        'w_out_mlstm': nrm((DEPTH, M_W, D), M_W ** -0.5),
        'w_o': nrm((DEPTH, D, D), D ** -0.5),
    }


def reference(x, c, ctx, c_ctx, mod_w, mod_b, norm_g, ffn1_w13, ffn1_w2, ffn2_w13, ffn2_w2,
              w_in, attn_q_norm, attn_k_norm, attn_sink, gla_w2, gla_b, gla_norm,
              mlstm_conv_w, mlstm_conv_b, mlstm_ib, mlstm_fb, mlstm_norm,
              w_out_attn, w_out_gla, w_out_mlstm, w_o):
    rows = x.shape[1] // GRID_W
    cos, sin = axial_rope(rows)
    for l in range(DEPTH):
        lp = {
            'mod_w': mod_w[l], 'mod_b': mod_b[l], 'norm_g': norm_g[l],
            'ffn1_w13': ffn1_w13[l], 'ffn1_w2': ffn1_w2[l],
            'ffn2_w13': ffn2_w13[l], 'ffn2_w2': ffn2_w2[l],
            'w_in': w_in[l], 'attn_q_norm': attn_q_norm[l], 'attn_k_norm': attn_k_norm[l],
            'attn_sink': attn_sink[l], 'gla_w2': gla_w2[l], 'gla_b': gla_b[l],
            'gla_norm': gla_norm[l], 'mlstm_conv_w': mlstm_conv_w[l],
            'mlstm_conv_b': mlstm_conv_b[l], 'mlstm_ib': mlstm_ib[l], 'mlstm_fb': mlstm_fb[l],
            'mlstm_norm': mlstm_norm[l], 'w_out_attn': w_out_attn[l], 'w_out_gla': w_out_gla[l],
            'w_out_mlstm': w_out_mlstm[l], 'w_o': w_o[l],
        }
        x, ctx = trunk_layer(x, ctx, c, c_ctx, cos, sin, lp, l == DEPTH - 1)
    return x
```

```cpp
#include <hip/hip_runtime.h>
#include <hip/hip_cooperative_groups.h>
#include <cstdio>
namespace cg = cooperative_groups;

#define DI __device__ __forceinline__
#define LAS __attribute__((address_space(3)))
typedef unsigned short bf16_t;
typedef unsigned char uchar;
typedef short bf16x8 __attribute__((ext_vector_type(8)));
typedef float f32x4 __attribute__((ext_vector_type(4)));
typedef float f32x2 __attribute__((ext_vector_type(2)));
typedef float f32x16 __attribute__((ext_vector_type(16)));
typedef unsigned u32x4 __attribute__((ext_vector_type(4)));
typedef unsigned u32x2 __attribute__((ext_vector_type(2)));
typedef __bf16 hbf2 __attribute__((ext_vector_type(2)));

constexpr int D = 1024, NBATCH = 4, SEQ = 8192, CTXL = 256, DFF = 2816, NMOD = 9;
constexpr int NLAT = NBATCH * SEQ, NCTX = NBATCH * CTXL, NTOK = NLAT + NCTX;
constexpr int HLAT = 2 * SEQ, HCTX = 2 * CTXL, HROWS = HLAT + HCTX;
constexpr int ZC = 7680;
constexpr int Z_AQ = 0, Z_AK = 512, Z_AV = 640, Z_GQ = 768, Z_GK = 1024, Z_GV = 1280, Z_GR = 1792, Z_GG = 2304,
              Z_MQ = 2336, Z_MK = 2848, Z_MV = 3360, Z_MO = 3872, Z_MI = 4384, Z_MF = 4392, Z_GATE = 4608, DIN = 7472, DIN_MIX = 4400;
constexpr int NSC = 33;
constexpr int LDS_BYTES = 147456;

constexpr size_t AL(size_t x) { return (x + 255) & ~(size_t)255; }
constexpr size_t WS_XC = 4096;
constexpr size_t WS_MOD = AL(WS_XC + (size_t)NCTX * D * 4);
constexpr size_t WS_ROPE = AL(WS_MOD + (size_t)2 * 5 * NMOD * D * 4);
constexpr size_t WS_WT = AL(WS_ROPE + 128 * 16 * 2 * 4);
constexpr size_t WT_W13A = 0, WT_W2A = WT_W13A + (size_t)2 * DFF * D, WT_WIN = WT_W2A + (size_t)D * DFF, WT_WOUT = WT_WIN + (size_t)ZC * D,
                 WT_WO = WT_WOUT + (size_t)3 * D * 512, WT_W13B = WT_WO + (size_t)D * D, WT_W2B = WT_W13B + (size_t)2 * DFF * D, WT_END = WT_W2B + (size_t)D * DFF;
constexpr size_t WS_XN = AL(WS_WT + WT_END * 2);
constexpr size_t XN_HALF = (size_t)HROWS * D * 2;
constexpr size_t ST_G_ELEMS = (size_t)16 * NSC * 128 * 64, ST_M_ELEMS = (size_t)16 * NSC * 129 * 128;
constexpr size_t WS_STG = WS_XN + XN_HALF;
constexpr size_t WS_STM = AL(WS_STG + ST_G_ELEMS * 2);
constexpr size_t WS_DG = AL(WS_STM + ST_M_ELEMS * 2);
constexpr size_t WS_DM = AL(WS_DG + (size_t)16 * NSC * 64 * 4);
constexpr size_t WS_ST_END = WS_DM + (size_t)16 * NSC * 128 * 4;
constexpr size_t WS_BIG = AL(WS_XN + (size_t)NTOK * D * 2);
constexpr size_t WS_PB = AL(WS_BIG + (size_t)HROWS * ZC * 2);
constexpr size_t PB_STRIDE = (size_t)HROWS * 512;
constexpr size_t WS_AOP = AL(WS_PB + 4 * PB_STRIDE * 2);
constexpr size_t WS_END = AL(WS_AOP + 3 * PB_STRIDE * 2);
static_assert(WS_ST_END <= WS_XN + (size_t)NTOK * D * 2, "scan states must fit in the second half of XN");
static_assert((size_t)NTOK * DFF * 2 <= (size_t)HROWS * ZC * 2, "h1 must fit in the z region");

struct Params {
    const float* in[27];
    float* out;
    uchar* ws;
};
enum { I_X = 0, I_C, I_CTX, I_CCTX, I_MODW, I_MODB, I_NORMG, I_F1W13, I_F1W2, I_F2W13, I_F2W2, I_WIN, I_AQN, I_AKN, I_SINK, I_GW2, I_GB, I_GNORM,
       I_CONVW, I_CONVB, I_MIB, I_MFB, I_MNORM, I_WOA, I_WOG, I_WOM, I_WO };

DI unsigned pk2(float lo, float hi) { f32x2 v = {lo, hi}; hbf2 b = __builtin_convertvector(v, hbf2); return __builtin_bit_cast(unsigned, b); }
DI bf16_t f2bf(float x) { return (bf16_t)(pk2(x, 0.f) & 0xffffu); }
DI float bf2f(unsigned b) { return __uint_as_float(b << 16); }
DI float bflo(unsigned w) { return __uint_as_float(w << 16); }
DI float bfhi(unsigned w) { return __uint_as_float(w & 0xffff0000u); }
DI void unpack8(const u32x4 w, float (&f)[8]) { f[0] = bflo(w.x); f[1] = bfhi(w.x); f[2] = bflo(w.y); f[3] = bfhi(w.y); f[4] = bflo(w.z); f[5] = bfhi(w.z); f[6] = bflo(w.w); f[7] = bfhi(w.w); }
DI u32x4 pack8(const float (&f)[8]) { u32x4 w; w.x = pk2(f[0], f[1]); w.y = pk2(f[2], f[3]); w.z = pk2(f[4], f[5]); w.w = pk2(f[6], f[7]); return w; }
DI float sigmoidf_(float x) { return 1.f / (1.f + __expf(-x)); }
DI float siluf_(float x) { return x / (1.f + __expf(-x)); }
DI float logsigmoidf_(float x) { return fminf(x, 0.f) - log1pf(__expf(-fabsf(x))); }
DI f32x16 zero16() { f32x16 z; for (int i = 0; i < 16; ++i) z[i] = 0.f; return z; }
DI f32x16 mfma32(bf16x8 a, bf16x8 b, f32x16 c) { return __builtin_amdgcn_mfma_f32_32x32x16_bf16(a, b, c, 0, 0, 0); }
DI int crow(int reg, int h) { return (reg & 3) + 8 * (reg >> 2) + 4 * h; }
DI bf16x8 lds_frag(const LAS uchar* p) { return *(const LAS bf16x8*)p; }
DI void block_sync() { __syncthreads(); }
DI int otid() { int t = threadIdx.x; asm volatile("" : "+v"(t)); return t; }

constexpr int BM = 256, BK = 64, HALF = 128, HTB = HALF * BK * 2, STAGE_BYTES = 8 * HTB, NXCD = 8, WGM = 8;
DI int lds_byte(int r, int c) { const int st = (r >> 4) * 2 + (c >> 5), rr = r & 15, cc = c & 31, ob = rr * 64 + cc * 2; return st * 1024 + (ob ^ (((ob >> 9) & 1) << 5)); }
DI void stage_rc(int b, int& R, int& C) { const int st = b / 1024, sb = b % 1024, swz = sb ^ (((sb >> 9) & 1) << 5); R = (st >> 1) * 16 + swz / 64; C = (st & 1) * 32 + (swz % 64) / 2; }
DI int perm32(int rho) { const int n = rho >> 4, i = rho & 15; return 8 * (i >> 2) + 4 * n + (i & 3); }

struct Unit { int pm, pn, g; const char* a; const char* b; };
struct Sched {
    int nM, nN, nwg, G, c, ng, K;
    const char* A0; const char* B0; size_t ags, bgs;
    DI void init(int nM_, int nN_, int K_, const void* A, const void* B, int ng_ = 1, size_t ags_ = 0, size_t bgs_ = 0) {
        nM = nM_; nN = nN_; nwg = nM * nN; G = (int)gridDim.x; c = (int)blockIdx.x; ng = ng_; K = K_; A0 = (const char*)A; B0 = (const char*)B; ags = ags_; bgs = bgs_; }
    DI bool next(int i, Unit& u) const {
        const int round = i / ng, g = i - round * ng;
        const long L = (long)round * G + c; if (L >= nwg) return false;
        int wgid = (int)L; { const int q = nwg / NXCD, r = nwg % NXCD, xcd = wgid % NXCD, off = wgid / NXCD; wgid = (xcd < r ? xcd * (q + 1) : r * (q + 1) + (xcd - r) * q) + off; }
        const int nig = WGM * nN, gid = wgid / nig, fm = gid * WGM, gsz = (nM - fm) < WGM ? (nM - fm) : WGM;
        u.pm = fm + ((wgid % nig) % gsz); u.pn = (wgid % nig) / gsz; u.g = g;
        const size_t tstep = (size_t)BM * K * 2;
        u.a = A0 + (size_t)g * ags + (size_t)u.pm * tstep; u.b = B0 + (size_t)g * bgs + (size_t)u.pn * tstep; return true;
    }
};

template <class Epi>
DI void gemm_phase(LAS uchar* lds, const Sched& S, const Epi& E) {
    const int tid = otid(), wid = __builtin_amdgcn_readfirstlane(tid >> 6), lane = tid & 63, wr = wid >> 2, wc = wid & 3, fr = lane & 15, fq = lane >> 4;
    const int K = S.K, nt = K / BK;
#define PG8_LAS LAS
    unsigned voffA[2], voffB[2];
#pragma unroll
    for (int i = 0; i < 2; ++i) { int R, C; stage_rc(tid * 16 + i * 8192, R, C); const int Rb = Epi::PERM ? ((R & ~31) + perm32(R & 31)) : R;
        voffA[i] = (unsigned)(R * K + C) * 2u; voffB[i] = (unsigned)(Rb * K + C) * 2u; }
    const size_t kstep = (size_t)(BK * 2);
    const size_t hstep = (size_t)HALF * K * 2;

    const unsigned ldsw = (unsigned)wid * 1024u;
    const int aoff = lds_byte(wr * 64 + fr, fq * 8), boff = lds_byte(wc * 32 + fr, fq * 8);
#define PG8_SA(b, h) (((b) * 2 + (h)) * HTB)
#define PG8_SB(b, h) ((4 + (b) * 2 + (h)) * HTB)
#define PG8_STAGE(bufoff, gbase, voff) do { _Pragma("unroll") for (int _i = 0; _i < 2; ++_i) \
        __builtin_amdgcn_global_load_lds((const unsigned*)((const char*)(gbase) + (voff)[_i]), (PG8_LAS unsigned*)(lds + (bufoff) + ldsw + _i * 8192), 16, 0, 0); } while (0)
#define PG8_LDA(dst, b, h) do { _Pragma("unroll") for (int m = 0; m < 4; ++m) _Pragma("unroll") for (int k = 0; k < 2; ++k) dst[m][k] = *(const PG8_LAS bf16x8*)(lds + PG8_SA(b, h) + aoff + m * 2048 + k * 1024); } while (0)
#define PG8_LDB(dst, b, h) do { _Pragma("unroll") for (int n = 0; n < 2; ++n) _Pragma("unroll") for (int k = 0; k < 2; ++k) dst[n][k] = *(const PG8_LAS bf16x8*)(lds + PG8_SB(b, h) + boff + n * 2048 + k * 1024); } while (0)
#define PG8_MMA(ai, bj, At, Bt) do { __builtin_amdgcn_s_setprio(1); _Pragma("unroll") for (int m = 0; m < 4; ++m) _Pragma("unroll") for (int n = 0; n < 2; ++n) _Pragma("unroll") for (int k = 0; k < 2; ++k) \
        acc[ai][bj][m][n] = __builtin_amdgcn_mfma_f32_16x16x32_bf16(Bt[n][k], At[m][k], acc[ai][bj][m][n], 0, 0, 0); __builtin_amdgcn_s_setprio(0); } while (0)
#define PG8_WAIT_V(n) asm volatile("s_waitcnt vmcnt(" #n ")" ::: "memory")
#define PG8_WAIT_L(n) asm volatile("s_waitcnt lgkmcnt(" #n ")" ::: "memory")
#define PG8_BAR __builtin_amdgcn_s_barrier()
#define PG8_SCHED __builtin_amdgcn_sched_barrier(0)
    Unit cur, nxt; int ui = 0;
    if (!S.next(0, cur)) return;
    f32x4 acc[2][2][4][2];
#pragma unroll
    for (int a = 0; a < 2; ++a)
#pragma unroll
        for (int b = 0; b < 2; ++b)
#pragma unroll
            for (int m = 0; m < 4; ++m)
#pragma unroll
                for (int n = 0; n < 2; ++n) acc[a][b][m][n] = (f32x4){0.f, 0.f, 0.f, 0.f};
    bf16x8 At[4][2], B0[2][2], B1[2][2];
    const char* cA = cur.a; const char* cB = cur.b;

    PG8_STAGE(PG8_SB(0, 0), cB, voffB); PG8_STAGE(PG8_SA(0, 0), cA, voffA); PG8_STAGE(PG8_SB(0, 1), cB + hstep, voffB); PG8_STAGE(PG8_SA(0, 1), cA + hstep, voffA);
    if (wr == 1) PG8_BAR;
    PG8_WAIT_V(4); PG8_BAR;
    PG8_STAGE(PG8_SB(1, 0), cB + kstep, voffB); PG8_STAGE(PG8_SA(1, 0), cA + kstep, voffA); PG8_STAGE(PG8_SB(1, 1), cB + hstep + kstep, voffB);
    PG8_WAIT_V(6); PG8_BAR;
    for (;;) {
        const bool has_next = S.next(ui + 1, nxt);
        const char* nA = has_next ? nxt.a : cA; const char* nB = has_next ? nxt.b : cB;
        for (int t = 0; t < nt; t += 2) {
            const bool last = (t == nt - 2);
            const char* a1 = cA + (size_t)(t + 1) * kstep;
            const char* a2 = last ? nA : cA + (size_t)(t + 2) * kstep; const char* b2 = last ? nB : cB + (size_t)(t + 2) * kstep;
            const char* a3 = a2 + kstep; const char* b3 = b2 + kstep;

            PG8_LDB(B0, 0, 0); PG8_SCHED; PG8_LDA(At, 0, 0); PG8_STAGE(PG8_SA(1, 1), a1 + hstep, voffA);
            PG8_WAIT_L(8); PG8_BAR; PG8_WAIT_L(0); PG8_MMA(0, 0, At, B0); PG8_BAR; PG8_SCHED;
            PG8_LDB(B1, 0, 1); PG8_STAGE(PG8_SB(0, 0), b2, voffB);
            PG8_BAR; PG8_WAIT_L(0); PG8_MMA(0, 1, At, B1); PG8_BAR;
            PG8_LDA(At, 0, 1); PG8_STAGE(PG8_SA(0, 0), a2, voffA);
            PG8_BAR; PG8_WAIT_L(0); PG8_MMA(1, 0, At, B0); PG8_BAR; PG8_SCHED;
            PG8_STAGE(PG8_SB(0, 1), b2 + hstep, voffB);
            PG8_WAIT_V(6); PG8_BAR; PG8_MMA(1, 1, At, B1); PG8_BAR;
            PG8_LDB(B0, 1, 0); PG8_SCHED; PG8_LDA(At, 1, 0); PG8_STAGE(PG8_SA(0, 1), a2 + hstep, voffA);
            PG8_WAIT_L(8); PG8_BAR; PG8_WAIT_L(0); PG8_MMA(0, 0, At, B0); PG8_BAR; PG8_SCHED;
            PG8_LDB(B1, 1, 1); PG8_STAGE(PG8_SB(1, 0), b3, voffB);
            PG8_BAR; PG8_WAIT_L(0); PG8_MMA(0, 1, At, B1); PG8_BAR;
            PG8_LDA(At, 1, 1); PG8_STAGE(PG8_SA(1, 0), a3, voffA);
            PG8_BAR; PG8_WAIT_L(0); PG8_MMA(1, 0, At, B0); PG8_BAR; PG8_SCHED;
            PG8_STAGE(PG8_SB(1, 1), b3 + hstep, voffB);
            PG8_WAIT_V(6); PG8_BAR; PG8_MMA(1, 1, At, B1); PG8_BAR;
        }
        E(acc, cur, wr, wc, fr, fq);
        if (!has_next) break;
#pragma unroll
        for (int a = 0; a < 2; ++a)
#pragma unroll
            for (int b = 0; b < 2; ++b)
#pragma unroll
                for (int m = 0; m < 4; ++m)
#pragma unroll
                    for (int n = 0; n < 2; ++n) acc[a][b][m][n] = (f32x4){0.f, 0.f, 0.f, 0.f};
        cur = nxt; cA = nA; cB = nB; ++ui;
    }
    PG8_WAIT_V(0);
    if (wr == 0) PG8_BAR;
    PG8_BAR;


#undef PG8_SA
#undef PG8_SB
#undef PG8_STAGE
#undef PG8_LDA
#undef PG8_LDB
#undef PG8_MMA
#undef PG8_WAIT_V
#undef PG8_WAIT_L
#undef PG8_BAR
#undef PG8_SCHED
}

DI int panel_grow(int pm, int hf) { return hf < 0 ? pm * 256 : (pm < 64 ? hf * HLAT + pm * 256 : NLAT + hf * HCTX + (pm - 64) * 256); }

struct EpiSwiGLU {
    static constexpr bool PERM = true;
    bf16_t* H;
    DI void operator()(const f32x4 (&acc)[2][2][4][2], const Unit& u, int wr, int wc, int fr, int fq) const {
        const int row0 = u.pm * BM + wr * 64 + fr, col0 = u.pn * 128 + wc * 32 + 8 * fq;
#pragma unroll
        for (int ai = 0; ai < 2; ++ai)
#pragma unroll
            for (int m = 0; m < 4; ++m) {
                bf16_t* rowp = H + (size_t)(row0 + ai * HALF + m * 16) * DFF + col0;
                const f32x4 a0 = acc[ai][0][m][0], a1 = acc[ai][0][m][1], b0 = acc[ai][1][m][0], b1 = acc[ai][1][m][1];
                u32x4 w;
                w.x = pk2(siluf_(a0[0]) * b0[0], siluf_(a0[1]) * b0[1]); w.y = pk2(siluf_(a0[2]) * b0[2], siluf_(a0[3]) * b0[3]);
                w.z = pk2(siluf_(a1[0]) * b1[0], siluf_(a1[1]) * b1[1]); w.w = pk2(siluf_(a1[2]) * b1[2], siluf_(a1[3]) * b1[3]);
                *(u32x4*)rowp = w;
            }
    }
};
struct EpiResid {
    static constexpr bool PERM = false;
    const float* in_lat; const float* in_ctx; float* out_lat; float* out_ctx; const float* mod; int mrow; float coef; int hf;
    DI void operator()(const f32x4 (&acc)[2][2][4][2], const Unit& u, int wr, int wc, int fr, int fq) const {
        const int grow0 = panel_grow(u.pm, hf); const bool isctx = grow0 >= NLAT; const int b = isctx ? 4 : grow0 / SEQ;
        const float* mp = mod + (size_t)b * (NMOD * D) + mrow * D;
        const float* ib = isctx ? in_ctx + (size_t)(grow0 - NLAT) * D : in_lat + (size_t)grow0 * D;
        float* ob = isctx ? out_ctx + (size_t)(grow0 - NLAT) * D : out_lat + (size_t)grow0 * D;
        const int r0 = wr * 64 + fr, c0 = u.pn * BM + wc * 32 + 4 * fq;
        f32x4 gv[2][2];
#pragma unroll
        for (int bj = 0; bj < 2; ++bj)
#pragma unroll
            for (int n = 0; n < 2; ++n) gv[bj][n] = *(const f32x4*)(mp + c0 + bj * HALF + n * 16) * coef;
#pragma unroll
        for (int ai = 0; ai < 2; ++ai)
#pragma unroll
            for (int m = 0; m < 4; ++m) {
                const size_t ro = (size_t)(r0 + ai * HALF + m * 16) * D + c0;
#pragma unroll
                for (int bj = 0; bj < 2; ++bj)
#pragma unroll
                    for (int n = 0; n < 2; ++n) {
                        const f32x4 xi = *(const f32x4*)(ib + ro + bj * HALF + n * 16);
                        *(f32x4*)(ob + ro + bj * HALF + n * 16) = xi + gv[bj][n] * acc[ai][bj][m][n];
                    }
            }
    }
};
struct EpiZ {
    static constexpr bool PERM = true;
    bf16_t* Z;
    DI void operator()(const f32x4 (&acc)[2][2][4][2], const Unit& u, int wr, int wc, int fr, int fq) const {
        const int row0 = u.pm * BM + wr * 64 + fr, col0 = u.pn * BM + wc * 32 + 8 * fq; const bool sg = u.pn >= (Z_GATE / BM);
#pragma unroll
        for (int ai = 0; ai < 2; ++ai)
#pragma unroll
            for (int m = 0; m < 4; ++m) {
                bf16_t* rowp = Z + (size_t)(row0 + ai * HALF + m * 16) * ZC + col0;
#pragma unroll
                for (int bj = 0; bj < 2; ++bj) {
                    f32x4 v0 = acc[ai][bj][m][0], v1 = acc[ai][bj][m][1];
                    if (sg) {
#pragma unroll
                        for (int k = 0; k < 4; ++k) { v0[k] = sigmoidf_(v0[k]); v1[k] = sigmoidf_(v1[k]); } }
                    u32x4 w; w.x = pk2(v0[0], v0[1]); w.y = pk2(v0[2], v0[3]); w.z = pk2(v1[0], v1[1]); w.w = pk2(v1[2], v1[3]);
                    *(u32x4*)(rowp + bj * HALF) = w;
                }
            }
    }
};
struct EpiMerge {
    static constexpr bool PERM = true;
    bf16_t* Y; const bf16_t* Z;
    DI void operator()(const f32x4 (&acc)[2][2][4][2], const Unit& u, int wr, int wc, int fr, int fq) const {
        const int row0 = u.pm * BM + wr * 64 + fr, col0 = u.pn * BM + wc * 32 + 8 * fq;
#pragma unroll
        for (int ai = 0; ai < 2; ++ai)
#pragma unroll
            for (int m = 0; m < 4; ++m) {
                const size_t row = (size_t)(row0 + ai * HALF + m * 16);
                bf16_t* yp = Y + row * D + col0; const bf16_t* gp = Z + row * ZC + Z_GATE + u.g * D + col0;
#pragma unroll
                for (int bj = 0; bj < 2; ++bj) {
                    const u32x4 gw = *(const u32x4*)(gp + bj * HALF);
                    float gf[8], yf[8]; unpack8(gw, gf);
                    if (u.g) { const u32x4 yw = *(const u32x4*)(yp + bj * HALF); unpack8(yw, yf); }
                    else {
#pragma unroll
                        for (int k = 0; k < 8; ++k) yf[k] = 0.f; }
                    const f32x4 v0 = acc[ai][bj][m][0], v1 = acc[ai][bj][m][1];
#pragma unroll
                    for (int k = 0; k < 4; ++k) { yf[k] += gf[k] * v0[k]; yf[4 + k] += gf[4 + k] * v1[k]; }
                    *(u32x4*)(yp + bj * HALF) = pack8(yf);
                }
            }
    }
};

DI float wave_sum(float v) {
#pragma unroll
    for (int o = 1; o < 64; o <<= 1) v += __shfl_xor(v, o);
    return v;
}

DI int wsrc(int np, int mode) {
    if (mode == 1) { const int pn = np >> 8, bj = (np >> 7) & 1, cc = np & 127; return bj * DFF + pn * 128 + cc; }
    if (mode == 2) return np < DIN_MIX ? np : (np < Z_GATE ? -1 : np - (Z_GATE - DIN_MIX));
    return np;
}
DI void conv_tile(LAS uchar* lds, const float* W, int K, int N, bf16_t* WT, int NP, int mode, int item) {
    LAS float* tile = (LAS float*)lds;
    const int ntn = NP / 128, kb = item / ntn, nb = item % ntn, k0 = kb * 64, n0 = nb * 128, tid = otid();
    { const int nl = tid & 127, kr0 = tid >> 7; const int src = wsrc(n0 + nl, mode);
#pragma unroll 4
      for (int i = 0; i < 16; ++i) { const int kr = kr0 + 4 * i; tile[kr * 129 + nl] = src >= 0 ? W[(size_t)(k0 + kr) * N + src] : 0.f; } }
    block_sync();
    { const int nl = tid >> 2, ks = (tid & 3) * 16; float f[8], g[8];
#pragma unroll
      for (int j = 0; j < 8; ++j) { f[j] = tile[(ks + j) * 129 + nl]; g[j] = tile[(ks + 8 + j) * 129 + nl]; }
      bf16_t* dst = WT + (size_t)(n0 + nl) * K + k0 + ks;
      *(u32x4*)dst = pack8(f); *(u32x4*)(dst + 8) = pack8(g); }
    block_sync();
}
DI void phase_convert(LAS uchar* lds, const Params& P, int layer) {
    bf16_t* WT = (bf16_t*)(P.ws + WS_WT);
    constexpr int I13 = (D / 64) * (2 * DFF / 128), I2 = (DFF / 64) * (D / 128), IIN = (D / 64) * (ZC / 128), IOUT = (512 / 64) * (D / 128), IO = (D / 64) * (D / 128);
    constexpr int NIT = 2 * I13 + 2 * I2 + IIN + 3 * IOUT + IO;
    for (int it = blockIdx.x; it < NIT; it += gridDim.x) {
        int r = it;
        if (r < I13) { conv_tile(lds, P.in[I_F1W13] + (size_t)layer * D * 2 * DFF, D, 2 * DFF, WT + WT_W13A, 2 * DFF, 1, r); continue; } r -= I13;
        if (r < I13) { conv_tile(lds, P.in[I_F2W13] + (size_t)layer * D * 2 * DFF, D, 2 * DFF, WT + WT_W13B, 2 * DFF, 1, r); continue; } r -= I13;
        if (r < I2) { conv_tile(lds, P.in[I_F1W2] + (size_t)layer * DFF * D, DFF, D, WT + WT_W2A, D, 0, r); continue; } r -= I2;
        if (r < I2) { conv_tile(lds, P.in[I_F2W2] + (size_t)layer * DFF * D, DFF, D, WT + WT_W2B, D, 0, r); continue; } r -= I2;
        if (r < IIN) { conv_tile(lds, P.in[I_WIN] + (size_t)layer * D * DIN, D, DIN, WT + WT_WIN, ZC, 2, r); continue; } r -= IIN;
        if (r < IOUT) { conv_tile(lds, P.in[I_WOA] + (size_t)layer * 512 * D, 512, D, WT + WT_WOUT, D, 0, r); continue; } r -= IOUT;
        if (r < IOUT) { conv_tile(lds, P.in[I_WOG] + (size_t)layer * 512 * D, 512, D, WT + WT_WOUT + (size_t)D * 512, D, 0, r); continue; } r -= IOUT;
        if (r < IOUT) { conv_tile(lds, P.in[I_WOM] + (size_t)layer * 512 * D, 512, D, WT + WT_WOUT + (size_t)2 * D * 512, D, 0, r); continue; } r -= IOUT;
        conv_tile(lds, P.in[I_WO] + (size_t)layer * D * D, D, D, WT + WT_WO, D, 0, r);
    }
}

DI void phase_mods(LAS uchar* lds, const Params& P) {
    LAS float* sc = (LAS float*)lds;
    LAS float* red = sc + 5 * D;
    const int tid = otid();
    for (int idx = tid; idx < 5 * D; idx += 512) { const int r = idx >> 10, k = idx & 1023; const float v = r < 4 ? P.in[I_C][r * D + k] : P.in[I_CCTX][k]; sc[idx] = siluf_(v); }
    block_sync();
    float* MOD = (float*)(P.ws + WS_MOD);
    const int col = tid & 63, kq = tid >> 6;
    for (int it = blockIdx.x; it < 2 * 144; it += gridDim.x) {
        const int l = it / 144, cb = it % 144;
        const float* w = P.in[I_MODW] + (size_t)l * D * (NMOD * D) + cb * 64 + col;
        float a0 = 0.f, a1 = 0.f, a2 = 0.f, a3 = 0.f, a4 = 0.f;
#pragma unroll 8
        for (int k = kq * 128; k < kq * 128 + 128; ++k) { const float wv = w[(size_t)k * (NMOD * D)]; a0 += sc[k] * wv; a1 += sc[D + k] * wv; a2 += sc[2 * D + k] * wv; a3 += sc[3 * D + k] * wv; a4 += sc[4 * D + k] * wv; }
        red[(kq * 5 + 0) * 64 + col] = a0; red[(kq * 5 + 1) * 64 + col] = a1; red[(kq * 5 + 2) * 64 + col] = a2; red[(kq * 5 + 3) * 64 + col] = a3; red[(kq * 5 + 4) * 64 + col] = a4;
        block_sync();
        if (tid < 320) { const int r = tid >> 6; float s = P.in[I_MODB][(size_t)l * NMOD * D + cb * 64 + col];
#pragma unroll
            for (int q = 0; q < 8; ++q) s += red[(q * 5 + r) * 64 + col];
            MOD[((size_t)l * 5 + r) * (NMOD * D) + cb * 64 + col] = s; }
        block_sync();
    }
}
__device__ const double ROPE_INV[16] = {1.0, 0.5623413251903491, 0.31622776601683794, 0.1778279410038923, 0.1, 0.05623413251903491, 0.031622776601683791, 0.01778279410038923,
                                        0.01, 0.005623413251903491, 0.0031622776601683794, 0.001778279410038923, 0.001, 0.0005623413251903491, 0.00031622776601683794, 0.0001778279410038923};
DI void phase_rope(const Params& P) {
    float* tab = (float*)(P.ws + WS_ROPE);
    for (int idx = blockIdx.x * 512 + otid(); idx < 128 * 16; idx += gridDim.x * 512) {
        const int p = idx >> 4, f = idx & 15;
        const float inv = (float)ROPE_INV[f]; const float angf = (float)p * inv;
        double rev = (double)angf * 0.15915494309189535; rev -= floor(rev);
        tab[idx * 2] = __builtin_amdgcn_cosf((float)rev); tab[idx * 2 + 1] = __builtin_amdgcn_sinf((float)rev);
    }
}

DI void phase_adaln(const Params& P, int layer, int j, const float* src_lat, const float* src_ctx, bf16_t* dst, int nrows, int hf) {
    const int tid = otid(), lane = tid & 63, wave = tid >> 6;
    const float* MOD = (const float*)(P.ws + WS_MOD) + (size_t)layer * 5 * NMOD * D;
    const float* gain = P.in[I_NORMG] + ((size_t)layer * 3 + j) * D;
    for (int lr = blockIdx.x * 8 + wave; lr < nrows; lr += gridDim.x * 8) {
        const int gr = hf < 0 ? lr : (lr < HLAT ? hf * HLAT + lr : NLAT + hf * HCTX + (lr - HLAT));
        const float* xr = gr < NLAT ? src_lat + (size_t)gr * D : src_ctx + (size_t)(gr - NLAT) * D;
        const int b = gr < NLAT ? gr / SEQ : 4;
        const float* sh = MOD + (size_t)b * NMOD * D + (3 * j) * D; const float* scl = sh + D;
        f32x4 v[4]; float ss = 0.f;
#pragma unroll
        for (int q = 0; q < 4; ++q) { v[q] = *(const f32x4*)(xr + q * 256 + lane * 4); ss += v[q][0] * v[q][0] + v[q][1] * v[q][1] + v[q][2] * v[q][2] + v[q][3] * v[q][3]; }
        ss = wave_sum(ss);
        const float rstd = rsqrtf(ss * (1.f / D) + 1e-6f);
#pragma unroll
        for (int q = 0; q < 4; ++q) {
            const int c = q * 256 + lane * 4;
            const f32x4 g = *(const f32x4*)(gain + c), s1 = *(const f32x4*)(scl + c), s0 = *(const f32x4*)(sh + c);
            const f32x4 y = v[q] * rstd * g * (s1 + 1.f) + s0;
            u32x2 w; w.x = pk2(y[0], y[1]); w.y = pk2(y[2], y[3]);
            *(u32x2*)(dst + (size_t)lr * D + c) = w;
        }
    }
}

constexpr int KS_STRIDE = 144, VT_STRIDE = 264, AT_KS = 0, AT_VT = 128 * KS_STRIDE;
DI void attn_item(LAS uchar* lds, const Params& P, int layer, const bf16_t* z, bf16_t* aout, int item) {
    const int tid = otid(), wave = tid >> 6, lane = tid & 63, r = lane & 31, hh = lane >> 5;
    const bool isctx = item >= 256;
    int lb, kvh, nb;
    if (!isctx) { lb = item >> 7; kvh = (item >> 6) & 1; nb = item & 63; } else { const int it = item - 256; lb = it >> 2; kvh = (it >> 1) & 1; nb = it & 1; }
    const int qbase = isctx ? HLAT + lb * CTXL + nb * 128 : lb * SEQ + nb * 128;
    const int g = wave >> 1, hq = kvh * 4 + g, qi0 = (wave & 1) * 64;
    const float* rope = (const float*)(P.ws + WS_ROPE);
    const float* qn = P.in[I_AQN] + layer * 64; const float* kn = P.in[I_AKN] + layer * 64;
    const float sink = P.in[I_SINK][layer * 8 + hq];
    LAS uchar* Ks = lds + AT_KS; LAS uchar* Vt = lds + AT_VT;

    bf16x8 Qf[2][4];
#pragma unroll
    for (int qt = 0; qt < 2; ++qt) {
        const int qi = qi0 + qt * 32 + r; const bf16_t* qp = z + (size_t)(qbase + qi) * ZC + Z_AQ + hq * 64 + 8 * hh;
        float f[4][8]; float ss = 0.f;
#pragma unroll
        for (int s = 0; s < 4; ++s) { unpack8(*(const u32x4*)(qp + 16 * s), f[s]);
#pragma unroll
            for (int j = 0; j < 8; ++j) ss += f[s][j] * f[s][j]; }
        ss += __shfl_xor(ss, 32);
        const float rstd = rsqrtf(ss * (1.f / 64.f) + 1e-6f);
#pragma unroll
        for (int s = 0; s < 4; ++s)
#pragma unroll
            for (int j = 0; j < 8; ++j) f[s][j] *= rstd * qn[16 * s + 8 * hh + j];
        if (!isctx) {
            const int pos = nb * 128 + qi;
#pragma unroll
            for (int s = 0; s < 2; ++s) {
                const float* tp = rope + ((size_t)((s == 0 ? (pos >> 6) : (pos & 63)) * 16 + 8 * hh)) * 2;
#pragma unroll
                for (int j = 0; j < 8; ++j) { const float c = tp[2 * j], sn = tp[2 * j + 1], x1 = f[s][j], x2 = f[s + 2][j]; f[s][j] = x1 * c - x2 * sn; f[s + 2][j] = x1 * sn + x2 * c; }
            }
        }
#pragma unroll
        for (int s = 0; s < 4; ++s) {
#pragma unroll
            for (int j = 0; j < 8; ++j) f[s][j] *= 0.125f;
            Qf[qt][s] = __builtin_bit_cast(bf16x8, pack8(f[s])); }
    }
    f32x16 O[2][2]; float mrun[2], lrun[2];
#pragma unroll
    for (int qt = 0; qt < 2; ++qt) { O[qt][0] = zero16(); O[qt][1] = zero16(); mrun[qt] = sink; lrun[qt] = 1.f; }

    for (int kb = 0; kb < 5; ++kb) {
        int krow0; bool kctx;
        if (kb < 3) { if (isctx) continue; const int kblk = nb + kb - 1; if (kblk < 0 || kblk >= SEQ / 128) continue; krow0 = lb * SEQ + kblk * 128; kctx = false; }
        else { krow0 = HLAT + lb * CTXL + (kb - 3) * 128; kctx = true; }
        block_sync();
        {
            const int key = tid >> 2, dq = tid & 3; const bf16_t* kp = z + (size_t)(krow0 + key) * ZC + Z_AK + kvh * 64 + dq * 8;
            float x1[8], x2[8]; unpack8(*(const u32x4*)kp, x1); unpack8(*(const u32x4*)(kp + 32), x2);
            float ss = 0.f;
#pragma unroll
            for (int j = 0; j < 8; ++j) ss += x1[j] * x1[j] + x2[j] * x2[j];
            ss += __shfl_xor(ss, 1); ss += __shfl_xor(ss, 2);
            const float rstd = rsqrtf(ss * (1.f / 64.f) + 1e-6f);
#pragma unroll
            for (int j = 0; j < 8; ++j) { x1[j] *= rstd * kn[dq * 8 + j]; x2[j] *= rstd * kn[32 + dq * 8 + j]; }
            if (!kctx) {
                const int pos = (nb + kb - 1) * 128 + key;
                const float* tp = rope + ((size_t)((dq < 2 ? (pos >> 6) : (pos & 63)) * 16 + (dq & 1) * 8)) * 2;
#pragma unroll
                for (int j = 0; j < 8; ++j) { const float c = tp[2 * j], sn = tp[2 * j + 1], a = x1[j], b = x2[j]; x1[j] = a * c - b * sn; x2[j] = a * sn + b * c; }
            }
            *(LAS u32x4*)(Ks + key * KS_STRIDE + dq * 16) = pack8(x1);
            *(LAS u32x4*)(Ks + key * KS_STRIDE + 64 + dq * 16) = pack8(x2);
            const bf16_t* vp = z + (size_t)(krow0 + key) * ZC + Z_AV + kvh * 64 + dq * 16;
            const u32x4 v0 = *(const u32x4*)vp, v1 = *(const u32x4*)(vp + 8);
            const unsigned vw[8] = {v0.x, v0.y, v0.z, v0.w, v1.x, v1.y, v1.z, v1.w};
#pragma unroll
            for (int i = 0; i < 8; ++i) {
                *(LAS bf16_t*)(Vt + (dq * 16 + 2 * i) * VT_STRIDE + key * 2) = (bf16_t)(vw[i] & 0xffffu);
                *(LAS bf16_t*)(Vt + (dq * 16 + 2 * i + 1) * VT_STRIDE + key * 2) = (bf16_t)(vw[i] >> 16); }
        }
        block_sync();
#pragma unroll 1
        for (int kt = 0; kt < 4; ++kt) {
            bf16x8 Kf[4];
#pragma unroll
            for (int s = 0; s < 4; ++s) Kf[s] = lds_frag(Ks + (kt * 32 + r) * KS_STRIDE + (16 * s + 8 * hh) * 2);
            bf16x8 Vf[2][2];
#pragma unroll
            for (int dt = 0; dt < 2; ++dt)
#pragma unroll
                for (int s = 0; s < 2; ++s) {
                    const LAS uchar* vp = Vt + (dt * 32 + r) * VT_STRIDE + (kt * 32 + 16 * s + 4 * hh) * 2;
                    const u32x2 lo = *(const LAS u32x2*)vp, hi = *(const LAS u32x2*)(vp + 16);
                    u32x4 w; w.x = lo.x; w.y = lo.y; w.z = hi.x; w.w = hi.y; Vf[dt][s] = __builtin_bit_cast(bf16x8, w); }
#pragma unroll
            for (int qt = 0; qt < 2; ++qt) {
                f32x16 S = zero16();
#pragma unroll
                for (int s = 0; s < 4; ++s) S = mfma32(Kf[s], Qf[qt][s], S);
                if (kb == 0 || kb == 2) {
                    const int qi = qi0 + qt * 32 + r;
#pragma unroll
                    for (int i = 0; i < 16; ++i) { const int kk = kt * 32 + crow(i, hh); const bool ok = (kb == 0) ? (kk >= qi) : (kk <= qi); S[i] = ok ? S[i] : -1e30f; }
                }
                float mx = S[0];
#pragma unroll
                for (int i = 1; i < 16; ++i) mx = fmaxf(mx, S[i]);
                mx = fmaxf(mx, __shfl_xor(mx, 32));
                const float mnew = fmaxf(mrun[qt], mx), alpha = __expf(mrun[qt] - mnew);
                float ps = 0.f;
#pragma unroll
                for (int i = 0; i < 16; ++i) { S[i] = __expf(S[i] - mnew); ps += S[i]; }
                ps += __shfl_xor(ps, 32);
                lrun[qt] = lrun[qt] * alpha + ps; mrun[qt] = mnew;
#pragma unroll
                for (int i = 0; i < 16; ++i) { O[qt][0][i] *= alpha; O[qt][1][i] *= alpha; }
#pragma unroll
                for (int s = 0; s < 2; ++s) {
                    u32x4 pw; pw.x = pk2(S[8 * s], S[8 * s + 1]); pw.y = pk2(S[8 * s + 2], S[8 * s + 3]); pw.z = pk2(S[8 * s + 4], S[8 * s + 5]); pw.w = pk2(S[8 * s + 6], S[8 * s + 7]);
                    const bf16x8 pf = __builtin_bit_cast(bf16x8, pw);
                    O[qt][0] = mfma32(Vf[0][s], pf, O[qt][0]); O[qt][1] = mfma32(Vf[1][s], pf, O[qt][1]);
                }
            }
        }
    }
#pragma unroll
    for (int qt = 0; qt < 2; ++qt) {
        const float invl = 1.f / lrun[qt]; const int qi = qi0 + qt * 32 + r;
        bf16_t* op = aout + (size_t)(qbase + qi) * 512 + hq * 64;
#pragma unroll
        for (int dt = 0; dt < 2; ++dt)
#pragma unroll
            for (int g4 = 0; g4 < 4; ++g4) {
                u32x2 w; w.x = pk2(O[qt][dt][4 * g4] * invl, O[qt][dt][4 * g4 + 1] * invl); w.y = pk2(O[qt][dt][4 * g4 + 2] * invl, O[qt][dt][4 * g4 + 3] * invl);
                *(u32x2*)(op + dt * 32 + 8 * g4 + 4 * hh) = w; }
    }
    block_sync();
}

template <int DK, bool ML>
DI void scan_item(LAS uchar* lds, const Params& P, int layer, const bf16_t* z, int ch, int s, bool full, bf16_t* stbuf, float* dbuf, bf16_t* pb) {
    constexpr int QSS = (DK + 8) * 2, TS = 144, NT = DK / 64, NE = ML ? 129 : 128;
    constexpr int O_QS = 0, O_KS = 17408, O_KST = 34816, O_VT = 53248, O_ST = 71680, O_ATT = 106496, O_BF = 115712, O_TOT = 132096, O_MISC = 134144;
    LAS uchar* QS = lds + O_QS; LAS uchar* KS = lds + O_KS; LAS uchar* KST = lds + O_KST; LAS uchar* VT = lds + O_VT; LAS uchar* ST = lds + O_ST; LAS uchar* ATT = lds + O_ATT;
    LAS float* BF = (LAS float*)(lds + O_BF); LAS float* TOT = (LAS float*)(lds + O_TOT);
    LAS float* bsc = (LAS float*)(lds + O_MISC); LAS float* gi = bsc + 64; LAS float* nvec = bsc + 128; LAS float* rsum = bsc + 256; LAS float* qnv = bsc + 384;
    const int tid = otid(), wave = tid >> 6, lane = tid & 63, r = lane & 31, hh = lane >> 5;
    const int dir = ch & 1, h = (ch >> 1) & 3, lb = ch >> 3;
    int seqlen, base_row, t0;
    if (s == 0) { seqlen = CTXL; base_row = HLAT + lb * CTXL; t0 = dir ? CTXL - 1 : 0; }
    else { const int sc = dir ? (32 - s) : (s - 1); seqlen = SEQ; base_row = lb * SEQ; t0 = sc * 256 + (dir ? 255 : 0); }
    const int tdir = dir ? -1 : 1;
    bf16_t* gst = stbuf + ((size_t)ch * NSC + s) * NE * DK;
    const int eb = wave & 3, dbase = (wave >> 2) * NT;
    f32x16 Sacc[NT]; float dsum[NT];
#pragma unroll
    for (int ti = 0; ti < NT; ++ti) { Sacc[ti] = zero16(); dsum[ti] = 0.f; }
    if (full) {
        for (int idx = tid; idx < 128 * DK / 8; idx += 512) { const int e = idx / (DK / 8), d8 = idx % (DK / 8); *(LAS u32x4*)(ST + e * QSS + d8 * 16) = *(const u32x4*)(gst + (size_t)e * DK + d8 * 8); }
        if (ML && tid < 128) nvec[tid] = bf2f(gst[(size_t)128 * DK + tid]);
        block_sync();
#pragma unroll
        for (int ti = 0; ti < NT; ++ti)
#pragma unroll
            for (int i = 0; i < 16; ++i) Sacc[ti][i] = bf2f(*(const LAS bf16_t*)(ST + (eb * 32 + crow(i, hh)) * QSS + ((dbase + ti) * 32 + r) * 2));
    } else if (ML && tid < 128) nvec[tid] = 0.f;

#pragma unroll 1
    for (int cc = 0; cc < 4; ++cc) {
        const int j = tid >> 3, dseg = tid & 7;
        const int tj = t0 + tdir * (cc * 64 + j); const size_t rowj = (size_t)(base_row + tj);
        if constexpr (!ML) {
            {
                const bf16_t* gp = z + rowj * ZC + Z_GG + dir * 16; float gf[16];
                { float t8[8]; unpack8(*(const u32x4*)gp, t8);
#pragma unroll
                  for (int k = 0; k < 8; ++k) gf[k] = t8[k];
                  unpack8(*(const u32x4*)(gp + 8), t8);
#pragma unroll
                  for (int k = 0; k < 8; ++k) gf[8 + k] = t8[k]; }
                const float* w2 = P.in[I_GW2] + (size_t)layer * 2 * 16 * 256 + dir * 16 * 256 + h * 64 + dseg * 8;
                const float* gb = P.in[I_GB] + (size_t)layer * 512 + dir * 256 + h * 64 + dseg * 8;
                f32x4 a0 = *(const f32x4*)gb, a1 = *(const f32x4*)(gb + 4);
#pragma unroll
                for (int rr = 0; rr < 16; ++rr) { a0 += *(const f32x4*)(w2 + rr * 256) * gf[rr]; a1 += *(const f32x4*)(w2 + rr * 256 + 4) * gf[rr]; }
#pragma unroll
                for (int k = 0; k < 4; ++k) { BF[j * 64 + dseg * 8 + k] = logsigmoidf_(a0[k]) * 0.0625f; BF[j * 64 + dseg * 8 + 4 + k] = logsigmoidf_(a1[k]) * 0.0625f; }
            }
            block_sync();
            {
                const int seg = tid >> 6, d = tid & 63; float v[8];
#pragma unroll
                for (int i = 0; i < 8; ++i) v[i] = BF[(seg * 8 + i) * 64 + d];
#pragma unroll
                for (int i = 1; i < 8; ++i) v[i] += v[i - 1];
                TOT[seg * 64 + d] = v[7];
                block_sync();
                float off = 0.f;
#pragma unroll
                for (int q = 0; q < 8; ++q) off += (q < seg) ? TOT[q * 64 + d] : 0.f;
#pragma unroll
                for (int i = 0; i < 8; ++i) BF[(seg * 8 + i) * 64 + d] = v[i] + off;
            }
            block_sync();
            {
                float bj[8], qf[8], kf[8];
#pragma unroll
                for (int k = 0; k < 8; ++k) bj[k] = BF[j * 64 + dseg * 8 + k];
                unpack8(*(const u32x4*)(z + rowj * ZC + Z_GQ + h * 64 + dseg * 8), qf);
                unpack8(*(const u32x4*)(z + rowj * ZC + Z_GK + h * 64 + dseg * 8), kf);
#pragma unroll
                for (int k = 0; k < 8; ++k) { qf[k] *= 0.125f * __expf(bj[k]); kf[k] *= __expf(-bj[k]); }
                *(LAS u32x4*)(QS + j * QSS + dseg * 16) = pack8(qf);
                const u32x4 kw = pack8(kf);
                *(LAS u32x4*)(KS + j * QSS + dseg * 16) = kw;
                const unsigned kwv[4] = {kw.x, kw.y, kw.z, kw.w};
#pragma unroll
                for (int k = 0; k < 4; ++k) { *(LAS bf16_t*)(KST + (dseg * 8 + 2 * k) * TS + j * 2) = (bf16_t)(kwv[k] & 0xffffu); *(LAS bf16_t*)(KST + (dseg * 8 + 2 * k + 1) * TS + j * 2) = (bf16_t)(kwv[k] >> 16); }
                const bf16_t* vp = z + rowj * ZC + Z_GV + h * 128 + dseg * 16;
                const u32x4 v0 = *(const u32x4*)vp, v1 = *(const u32x4*)(vp + 8);
                const unsigned vw[8] = {v0.x, v0.y, v0.z, v0.w, v1.x, v1.y, v1.z, v1.w};
#pragma unroll
                for (int k = 0; k < 8; ++k) { *(LAS bf16_t*)(VT + (dseg * 16 + 2 * k) * TS + j * 2) = (bf16_t)(vw[k] & 0xffffu); *(LAS bf16_t*)(VT + (dseg * 16 + 2 * k + 1) * TS + j * 2) = (bf16_t)(vw[k] >> 16); }
            }
        } else {
            if (wave == 0) {
                const int tl = t0 + tdir * (cc * 64 + lane); const bf16_t* zp = z + (size_t)(base_row + tl) * ZC;
                const float mf = bf2f(zp[Z_MF + dir * 4 + h]) + P.in[I_MFB][layer * 8 + dir * 4 + h];
                const float mi = bf2f(zp[Z_MI + dir * 4 + h]) + P.in[I_MIB][layer * 8 + dir * 4 + h];
                float x = logsigmoidf_(mf);
#pragma unroll
                for (int o = 1; o < 64; o <<= 1) { const float y = __shfl_up(x, o); if (lane >= o) x += y; }
                bsc[lane] = x; gi[lane] = mi;
            }
            block_sync();
            {
                const float bjv = bsc[j], eq = __expf(bjv), ek = 0.08838834764831845f * __expf(gi[j] - bjv);
                const float* cw = P.in[I_CONVW] + (size_t)layer * 5 * 1024; const float* cbp = P.in[I_CONVB] + (size_t)layer * 1024;
#pragma unroll
                for (int part = 0; part < 4; ++part) {
                    const int isk = part >> 1, c8 = dseg * 16 + (part & 1) * 8, cch = isk * 512 + h * 128 + c8;
                    float a[8];
                    { const f32x4 b0 = *(const f32x4*)(cbp + cch), b1 = *(const f32x4*)(cbp + cch + 4);
#pragma unroll
                      for (int k = 0; k < 4; ++k) { a[k] = b0[k]; a[4 + k] = b1[k]; } }
#pragma unroll
                    for (int tau = 0; tau < 5; ++tau) {
                        const int tt = tj + tau - 2;
                        if (tt >= 0 && tt < seqlen) {
                            float xf[8]; unpack8(*(const u32x4*)(z + (size_t)(base_row + tt) * ZC + Z_MQ + cch), xf);
                            const f32x4 w0 = *(const f32x4*)(cw + tau * 1024 + cch), w1 = *(const f32x4*)(cw + tau * 1024 + cch + 4);
#pragma unroll
                            for (int k = 0; k < 4; ++k) { a[k] += w0[k] * xf[k]; a[4 + k] += w1[k] * xf[4 + k]; }
                        }
                    }
                    const float sc = isk ? ek : eq;
#pragma unroll
                    for (int k = 0; k < 8; ++k) a[k] = siluf_(a[k]) * sc;
                    const u32x4 w = pack8(a);
                    if (!isk) *(LAS u32x4*)(QS + j * QSS + c8 * 2) = w;
                    else {
                        *(LAS u32x4*)(KS + j * QSS + c8 * 2) = w;
                        const unsigned wv[4] = {w.x, w.y, w.z, w.w};
#pragma unroll
                        for (int k = 0; k < 4; ++k) { *(LAS bf16_t*)(KST + (c8 + 2 * k) * TS + j * 2) = (bf16_t)(wv[k] & 0xffffu); *(LAS bf16_t*)(KST + (c8 + 2 * k + 1) * TS + j * 2) = (bf16_t)(wv[k] >> 16); }
                    }
                }
                const bf16_t* vp = z + rowj * ZC + Z_MV + h * 128 + dseg * 16;
                const u32x4 v0 = *(const u32x4*)vp, v1 = *(const u32x4*)(vp + 8);
                const unsigned vw[8] = {v0.x, v0.y, v0.z, v0.w, v1.x, v1.y, v1.z, v1.w};
#pragma unroll
                for (int k = 0; k < 8; ++k) { *(LAS bf16_t*)(VT + (dseg * 16 + 2 * k) * TS + j * 2) = (bf16_t)(vw[k] & 0xffffu); *(LAS bf16_t*)(VT + (dseg * 16 + 2 * k + 1) * TS + j * 2) = (bf16_t)(vw[k] >> 16); }
            }
        }
        block_sync();
        if (full) {
            if (wave < 4) {
                const int jb = wave >> 1, ib = wave & 1, itok = ib * 32 + r;
                f32x16 a = zero16();
                if (jb <= ib) {
#pragma unroll
                    for (int k = 0; k < DK / 16; ++k) a = mfma32(lds_frag(KS + (jb * 32 + r) * QSS + (16 * k + 8 * hh) * 2), lds_frag(QS + (ib * 32 + r) * QSS + (16 * k + 8 * hh) * 2), a);
#pragma unroll
                    for (int i = 0; i < 16; ++i) { const int jt = jb * 32 + crow(i, hh); a[i] = (jt <= itok) ? a[i] : 0.f; }
                }
                if (ML) { float rs = 0.f;
#pragma unroll
                    for (int i = 0; i < 16; ++i) rs += a[i];
                    rs += __shfl_xor(rs, 32); if (hh == 0) rsum[jb * 64 + itok] = rs; }
#pragma unroll
                for (int g4 = 0; g4 < 4; ++g4) { u32x2 w; w.x = pk2(a[4 * g4], a[4 * g4 + 1]); w.y = pk2(a[4 * g4 + 2], a[4 * g4 + 3]); *(LAS u32x2*)(ATT + itok * TS + (jb * 32 + 8 * g4 + 4 * hh) * 2) = w; }
            } else if (ML && wave == 4) {
                float acc = 0.f;
#pragma unroll 4
                for (int d8 = 0; d8 < DK / 8; ++d8) { float qf[8]; unpack8(*(const LAS u32x4*)(QS + lane * QSS + d8 * 16), qf);
#pragma unroll
                    for (int k = 0; k < 8; ++k) acc += qf[k] * nvec[d8 * 8 + k]; }
                qnv[lane] = acc;
            }
            block_sync();
            {
                const int ib = wave >> 2;
                f32x16 a = zero16();
#pragma unroll
                for (int k = 0; k < 4; ++k) a = mfma32(lds_frag(ATT + (ib * 32 + r) * TS + (16 * k + 8 * hh) * 2), lds_frag(VT + (eb * 32 + r) * TS + (16 * k + 8 * hh) * 2), a);
#pragma unroll
                for (int k = 0; k < DK / 16; ++k) a = mfma32(lds_frag(QS + (ib * 32 + r) * QSS + (16 * k + 8 * hh) * 2), lds_frag(ST + (eb * 32 + r) * QSS + (16 * k + 8 * hh) * 2), a);
#pragma unroll
                for (int i = 0; i < 16; ++i) {
                    const int itok = ib * 32 + crow(i, hh); float val = a[i];
                    if (ML) { const float den = rsum[itok] + rsum[64 + itok] + qnv[itok]; val = val / fmaxf(fabsf(den), 1.f); }
                    const size_t row = (size_t)(base_row + t0 + tdir * (cc * 64 + itok));
                    pb[((size_t)dir * HROWS + row) * 512 + h * 128 + eb * 32 + r] = f2bf(val);
                }
            }
            block_sync();
        }
        {
#pragma unroll
            for (int ti = 0; ti < NT; ++ti) {
                const int db = dbase + ti;
#pragma unroll
                for (int k = 0; k < 4; ++k) Sacc[ti] = mfma32(lds_frag(VT + (eb * 32 + r) * TS + (16 * k + 8 * hh) * 2), lds_frag(KST + (db * 32 + r) * TS + (16 * k + 8 * hh) * 2), Sacc[ti]);
                const float bl = ML ? bsc[63] : BF[63 * 64 + db * 32 + r]; const float dec = __expf(bl);
#pragma unroll
                for (int i = 0; i < 16; ++i) Sacc[ti][i] *= dec;
                dsum[ti] += bl;
                if (full) {
#pragma unroll
                    for (int i = 0; i < 16; ++i) *(LAS bf16_t*)(ST + (eb * 32 + crow(i, hh)) * QSS + (db * 32 + r) * 2) = f2bf(Sacc[ti][i]);
                }
            }
            if (ML && tid < 128) {
                float nn = nvec[tid];
#pragma unroll
                for (int q = 0; q < 8; ++q) { float kf[8]; unpack8(*(const LAS u32x4*)(KST + tid * TS + q * 16), kf);
#pragma unroll
                    for (int k = 0; k < 8; ++k) nn += kf[k]; }
                nvec[tid] = nn * __expf(bsc[63]);
            }
        }
        block_sync();
    }
    if (!full) {
#pragma unroll
        for (int ti = 0; ti < NT; ++ti) {
            const int db = dbase + ti;
#pragma unroll
            for (int i = 0; i < 16; ++i) gst[(size_t)(eb * 32 + crow(i, hh)) * DK + db * 32 + r] = f2bf(Sacc[ti][i]);
            if (eb == 0 && hh == 0) dbuf[((size_t)ch * NSC + s) * DK + db * 32 + r] = __expf(dsum[ti]);
        }
        if (ML && tid < 128) gst[(size_t)128 * DK + tid] = f2bf(nvec[tid]);
    }
    block_sync();
}

DI void phase_scan_carry(const Params& P) {
    constexpr int NG = 16 * 128 * 8, NM = 16 * 129 * 16;
    for (int idx = blockIdx.x * 512 + otid(); idx < NG + NM; idx += gridDim.x * 512) {
        bf16_t* st; const float* dp; size_t sstride; int dstride;
        if (idx < NG) { const int ch = idx >> 10, rem = idx & 1023, e = rem >> 3, d8 = rem & 7;
            st = (bf16_t*)(P.ws + WS_STG) + (size_t)ch * NSC * 128 * 64 + e * 64 + d8 * 8; sstride = 128 * 64; dp = (const float*)(P.ws + WS_DG) + (size_t)ch * NSC * 64 + d8 * 8; dstride = 64; }
        else { const int i2 = idx - NG, ch = i2 / (129 * 16), rem = i2 % (129 * 16), e = rem >> 4, d8 = rem & 15;
            st = (bf16_t*)(P.ws + WS_STM) + (size_t)ch * NSC * 129 * 128 + e * 128 + d8 * 8; sstride = 129 * 128; dp = (const float*)(P.ws + WS_DM) + (size_t)ch * NSC * 128 + d8 * 8; dstride = 128; }
        float carry[8];
#pragma unroll
        for (int k = 0; k < 8; ++k) carry[k] = 0.f;
#pragma unroll 4
        for (int s = 0; s < NSC - 1; ++s) {
            float L[8]; unpack8(*(const u32x4*)(st + s * sstride), L);
            const f32x4 d0 = *(const f32x4*)(dp + s * dstride), d1 = *(const f32x4*)(dp + s * dstride + 4);
            *(u32x4*)(st + s * sstride) = pack8(carry);
#pragma unroll
            for (int k = 0; k < 4; ++k) { carry[k] = d0[k] * carry[k] + L[k]; carry[4 + k] = d1[k] * carry[4 + k] + L[4 + k]; }
        }
        *(u32x4*)(st + (size_t)(NSC - 1) * sstride) = pack8(carry);
    }
}

DI void phase_merge_prep(const Params& P, int layer, int nrows) {
    const int tid = otid(), lane = tid & 63, wave = tid >> 6, c = lane * 8;
    const bf16_t* z = (const bf16_t*)(P.ws + WS_BIG); const bf16_t* pb = (const bf16_t*)(P.ws + WS_PB); bf16_t* aop = (bf16_t*)(P.ws + WS_AOP);
    for (int lr = blockIdx.x * 8 + wave; lr < nrows; lr += gridDim.x * 8) {
#pragma unroll
        for (int mx = 0; mx < 2; ++mx) {
            float a[8], b[8], gt[8];
            unpack8(*(const u32x4*)(pb + (size_t)(2 * mx) * PB_STRIDE + (size_t)lr * 512 + c), a);
            unpack8(*(const u32x4*)(pb + (size_t)(2 * mx + 1) * PB_STRIDE + (size_t)lr * 512 + c), b);
            unpack8(*(const u32x4*)(z + (size_t)lr * ZC + (mx ? Z_MO : Z_GR) + c), gt);
            float ss = 0.f;
#pragma unroll
            for (int k = 0; k < 8; ++k) { a[k] += b[k]; ss += a[k] * a[k]; }
            ss += __shfl_xor(ss, 1); ss += __shfl_xor(ss, 2); ss += __shfl_xor(ss, 4); ss += __shfl_xor(ss, 8);
            const float rstd = rsqrtf(ss * (1.f / 128.f) + 1e-6f);
            const float* gn = (mx ? P.in[I_MNORM] : P.in[I_GNORM]) + layer * 128 + (c & 127);
#pragma unroll
            for (int k = 0; k < 8; ++k) a[k] = a[k] * rstd * gn[k] * (mx ? sigmoidf_(gt[k]) : siluf_(gt[k]));
            *(u32x4*)(aop + (size_t)(1 + mx) * PB_STRIDE + (size_t)lr * 512 + c) = pack8(a);
        }
    }
}

__global__ void __launch_bounds__(512, 2) hybrid_fwd(Params P) {
    extern __shared__ __attribute__((aligned(16))) uchar shm[];
    LAS uchar* lds = (LAS uchar*)shm;
    cg::grid_group grid = cg::this_grid();
    uchar* ws = P.ws;
    bf16_t* WT = (bf16_t*)(ws + WS_WT); bf16_t* XN = (bf16_t*)(ws + WS_XN); bf16_t* BIG = (bf16_t*)(ws + WS_BIG); bf16_t* AOP = (bf16_t*)(ws + WS_AOP); bf16_t* PB = (bf16_t*)(ws + WS_PB);
    float* XC = (float*)(ws + WS_XC); const float* MOD = (const float*)(ws + WS_MOD);
    phase_mods(lds, P); phase_rope(P);
    for (int layer = 0; layer < 2; ++layer) {
        const bool last = layer == 1;
        const float* xl = layer == 0 ? P.in[I_X] : P.out; const float* xc = layer == 0 ? P.in[I_CTX] : XC;
        const float* modl = MOD + (size_t)layer * 5 * NMOD * D;
        phase_convert(lds, P, layer);
        grid.sync();
        phase_adaln(P, layer, 0, xl, xc, XN, NTOK, -1);
        grid.sync();
        { Sched S; S.init(NTOK / BM, 2 * DFF / BM, D, XN, WT + WT_W13A); EpiSwiGLU E{BIG}; gemm_phase(lds, S, E); }
        grid.sync();
        { Sched S; S.init(NTOK / BM, D / BM, DFF, BIG, WT + WT_W2A); EpiResid E{xl, xc, P.out, XC, modl, 2, 0.5f, -1}; gemm_phase(lds, S, E); }
        grid.sync();
        const int nMh = last ? HLAT / BM : HROWS / BM;
        for (int hf = 0; hf < 2; ++hf) {
            phase_adaln(P, layer, 1, P.out, XC, XN, HROWS, hf);
            grid.sync();
            { Sched S; S.init(HROWS / BM, ZC / BM, D, XN, WT + WT_WIN); EpiZ E{BIG}; gemm_phase(lds, S, E); }
            grid.sync();
            {
                const int natt = last ? 256 : 264;
                for (int it = blockIdx.x; it < 1024 + natt; it += gridDim.x) {
                    if (it < 512) scan_item<64, false>(lds, P, layer, BIG, it >> 5, it & 31, false, (bf16_t*)(ws + WS_STG), (float*)(ws + WS_DG), nullptr);
                    else if (it < 1024) scan_item<128, true>(lds, P, layer, BIG, (it - 512) >> 5, it & 31, false, (bf16_t*)(ws + WS_STM), (float*)(ws + WS_DM), nullptr);
                    else attn_item(lds, P, layer, BIG, AOP, it - 1024);
                }
            }
            grid.sync();
            phase_scan_carry(P);
            grid.sync();
            {
                const int s0 = last ? 1 : 0, ns = NSC - s0;
                for (int it = blockIdx.x; it < 2 * 16 * ns; it += gridDim.x) {
                    const int mx = it / (16 * ns), rem = it % (16 * ns), ch = rem / ns, s = s0 + rem % ns;
                    if (mx == 0) scan_item<64, false>(lds, P, layer, BIG, ch, s, true, (bf16_t*)(ws + WS_STG), nullptr, PB);
                    else scan_item<128, true>(lds, P, layer, BIG, ch, s, true, (bf16_t*)(ws + WS_STM), nullptr, PB + 2 * PB_STRIDE);
                }
            }
            grid.sync();
            phase_merge_prep(P, layer, last ? HLAT : HROWS);
            grid.sync();
            { Sched S; S.init(nMh, D / BM, 512, AOP, WT + WT_WOUT, 3, PB_STRIDE * 2, (size_t)D * 512 * 2); EpiMerge E{XN, BIG}; gemm_phase(lds, S, E); }
            grid.sync();
            { Sched S; S.init(nMh, D / BM, D, XN, WT + WT_WO); EpiResid E{P.out, XC, P.out, XC, modl, 5, 1.0f, hf}; gemm_phase(lds, S, E); }
            grid.sync();
        }
        const int nrows2 = last ? NLAT : NTOK;
        phase_adaln(P, layer, 2, P.out, XC, XN, nrows2, -1);
        grid.sync();
        { Sched S; S.init(nrows2 / BM, 2 * DFF / BM, D, XN, WT + WT_W13B); EpiSwiGLU E{BIG}; gemm_phase(lds, S, E); }
        grid.sync();
        { Sched S; S.init(nrows2 / BM, D / BM, DFF, BIG, WT + WT_W2B); EpiResid E{P.out, XC, P.out, XC, modl, 8, 0.5f, -1}; gemm_phase(lds, S, E); }
        grid.sync();
    }
}

extern "C" void kernel_launch(void* const* d_in, const int* in_sizes, int n_in, void* d_out, int out_size, void* d_ws, size_t ws_size, hipStream_t stream) {
    static int grid_blocks = 0;
    if (!grid_blocks) {
        int dev = 0, cus = 0, per_cu = 0;
        hipGetDevice(&dev);
        hipDeviceGetAttribute(&cus, hipDeviceAttributeMultiprocessorCount, dev);
        hipFuncSetAttribute((const void*)hybrid_fwd, hipFuncAttributeMaxDynamicSharedMemorySize, LDS_BYTES);
        hipOccupancyMaxActiveBlocksPerMultiprocessor(&per_cu, (const void*)hybrid_fwd, 512, LDS_BYTES);
        if (per_cu < 1) per_cu = 1;
        grid_blocks = cus * (per_cu > 1 ? 1 : per_cu);
        if (ws_size < WS_END) fprintf(stderr, "kernel_launch: workspace too small: %zu < %zu\n", ws_size, (size_t)WS_END);
    }
    Params p{};
    for (int i = 0; i < 27; ++i) p.in[i] = (const float*)d_in[i];
    p.out = (float*)d_out; p.ws = (uchar*)d_ws;
    void* args[] = {&p};
    hipError_t e = hipLaunchCooperativeKernel((const void*)hybrid_fwd, dim3(grid_blocks), dim3(512), args, LDS_BYTES, stream);
    if (e != hipSuccess) fprintf(stderr, "cooperative launch failed: %s (grid %d)\n", hipGetErrorString(e), grid_blocks);
}
```

```cpp
#include <hip/hip_runtime.h>
#include <hip/hip_cooperative_groups.h>
#include <cstdio>
namespace cg = cooperative_groups;

#define DI __device__ __forceinline__
#define LAS __attribute__((address_space(3)))
typedef unsigned short bf16_t;
typedef unsigned char uchar;
typedef short bf16x8 __attribute__((ext_vector_type(8)));
typedef float f32x4 __attribute__((ext_vector_type(4)));
typedef float f32x2 __attribute__((ext_vector_type(2)));
typedef float f32x16 __attribute__((ext_vector_type(16)));
typedef unsigned u32x4 __attribute__((ext_vector_type(4)));
typedef unsigned u32x2 __attribute__((ext_vector_type(2)));
typedef __bf16 hbf2 __attribute__((ext_vector_type(2)));

constexpr int D = 1024, NBATCH = 4, SEQ = 8192, CTXL = 256, DFF = 2816, NMOD = 9;
constexpr int NLAT = NBATCH * SEQ, NCTX = NBATCH * CTXL, NTOK = NLAT + NCTX;
constexpr int HLAT = 2 * SEQ, HCTX = 2 * CTXL, HROWS = HLAT + HCTX;
constexpr int ZC = 7680;
constexpr int Z_AQ = 0, Z_AK = 512, Z_AV = 640, Z_GQ = 768, Z_GK = 1024, Z_GV = 1280, Z_GR = 1792, Z_GG = 2304,
              Z_MQ = 2336, Z_MK = 2848, Z_MV = 3360, Z_MO = 3872, Z_MI = 4384, Z_MF = 4392, Z_GATE = 4608, DIN = 7472, DIN_MIX = 4400;
constexpr int NSC = 33;
constexpr int LDS_BYTES = 147456;

constexpr size_t AL(size_t x) { return (x + 255) & ~(size_t)255; }
constexpr size_t WS_CTR = 14336;
constexpr size_t WS_CTL_BYTES = 16384;
constexpr size_t WS_XC = 16384;
constexpr size_t WS_MOD = AL(WS_XC + (size_t)NCTX * D * 4);
constexpr size_t WS_ROPE = AL(WS_MOD + (size_t)2 * 5 * NMOD * D * 4);
constexpr size_t WS_WT = AL(WS_ROPE + 128 * 16 * 2 * 4);
constexpr size_t WT_W13A = 0, WT_W2A = WT_W13A + (size_t)2 * DFF * D, WT_WIN = WT_W2A + (size_t)D * DFF, WT_WOUT = WT_WIN + (size_t)ZC * D,
                 WT_WO = WT_WOUT + (size_t)3 * D * 512, WT_W13B = WT_WO + (size_t)D * D, WT_W2B = WT_W13B + (size_t)2 * DFF * D, WT_END = WT_W2B + (size_t)D * DFF;
constexpr size_t WS_XN = AL(WS_WT + WT_END * 2);
constexpr size_t XN_HALF = (size_t)HROWS * D * 2;
constexpr size_t ST_G_ELEMS = (size_t)16 * NSC * 128 * 64, ST_M_ELEMS = (size_t)16 * NSC * 129 * 128;
constexpr size_t WS_STG = WS_XN + XN_HALF;
constexpr size_t WS_STM = AL(WS_STG + ST_G_ELEMS * 2);
constexpr size_t WS_DG = AL(WS_STM + ST_M_ELEMS * 2);
constexpr size_t WS_DM = AL(WS_DG + (size_t)16 * NSC * 64 * 4);
constexpr size_t WS_ST_END = WS_DM + (size_t)16 * NSC * 128 * 4;
constexpr size_t WS_BIG = AL(WS_XN + (size_t)NTOK * D * 2);
constexpr size_t WS_PB = AL(WS_BIG + (size_t)HROWS * ZC * 2);
constexpr size_t PB_STRIDE = (size_t)HROWS * 512;
constexpr size_t WS_AOP = AL(WS_PB + 4 * PB_STRIDE * 2);
constexpr size_t WS_WOPART = AL(WS_AOP + 3 * PB_STRIDE * 2);
constexpr size_t WS_YPART = AL(WS_WOPART + (size_t)2 * 4 * HCTX * D * 4);
constexpr size_t WS_END = AL(WS_YPART + (size_t)3 * HCTX * D * 4);
static_assert(WS_ST_END <= WS_XN + (size_t)NTOK * D * 2, "scan states must fit in the second half of XN");
static_assert((size_t)NTOK * DFF * 2 <= (size_t)HROWS * ZC * 2, "h1 must fit in the z region");

struct Params {
    const float* in[27];
    float* out;
    uchar* ws;
};
enum { I_X = 0, I_C, I_CTX, I_CCTX, I_MODW, I_MODB, I_NORMG, I_F1W13, I_F1W2, I_F2W13, I_F2W2, I_WIN, I_AQN, I_AKN, I_SINK, I_GW2, I_GB, I_GNORM,
       I_CONVW, I_CONVB, I_MIB, I_MFB, I_MNORM, I_WOA, I_WOG, I_WOM, I_WO };

DI unsigned pk2(float lo, float hi) { f32x2 v = {lo, hi}; hbf2 b = __builtin_convertvector(v, hbf2); return __builtin_bit_cast(unsigned, b); }
DI bf16_t f2bf(float x) { return (bf16_t)(pk2(x, 0.f) & 0xffffu); }
DI float bf2f(unsigned b) { return __uint_as_float(b << 16); }
DI float bflo(unsigned w) { return __uint_as_float(w << 16); }
DI float bfhi(unsigned w) { return __uint_as_float(w & 0xffff0000u); }
DI void unpack8(const u32x4 w, float (&f)[8]) { f[0] = bflo(w.x); f[1] = bfhi(w.x); f[2] = bflo(w.y); f[3] = bfhi(w.y); f[4] = bflo(w.z); f[5] = bfhi(w.z); f[6] = bflo(w.w); f[7] = bfhi(w.w); }
DI u32x4 pack8(const float (&f)[8]) { u32x4 w; w.x = pk2(f[0], f[1]); w.y = pk2(f[2], f[3]); w.z = pk2(f[4], f[5]); w.w = pk2(f[6], f[7]); return w; }
DI float sigmoidf_(float x) { return __builtin_amdgcn_rcpf(1.f + __expf(-x)); }
DI float siluf_(float x) { return x * __builtin_amdgcn_rcpf(1.f + __expf(-x)); }
DI float logsigmoidf_(float x) { return fminf(x, 0.f) - __logf(1.f + __expf(-fabsf(x))); }
DI f32x16 zero16() { f32x16 z; for (int i = 0; i < 16; ++i) z[i] = 0.f; return z; }
DI f32x16 mfma32(bf16x8 a, bf16x8 b, f32x16 c) { return __builtin_amdgcn_mfma_f32_32x32x16_bf16(a, b, c, 0, 0, 0); }
DI int crow(int reg, int h) { return (reg & 3) + 8 * (reg >> 2) + 4 * h; }
DI bf16x8 lds_frag(const LAS uchar* p) { return *(const LAS bf16x8*)p; }
DI void block_sync() { __syncthreads(); }
DI int otid() { int t = threadIdx.x; asm volatile("" : "+v"(t)); return t; }

typedef unsigned u32x2v __attribute__((ext_vector_type(2)));
DI float xsum32(float x) { const u32x2v r = __builtin_amdgcn_permlane32_swap(__float_as_uint(x), __float_as_uint(x), false, false); return __uint_as_float(r.x) + __uint_as_float(r.y); }
DI float xmax32(float x) { const u32x2v r = __builtin_amdgcn_permlane32_swap(__float_as_uint(x), __float_as_uint(x), false, false); return fmaxf(__uint_as_float(r.x), __uint_as_float(r.y)); }
template <int CTRL, int RMASK> DI float dpp_add(float v) { return v + __int_as_float(__builtin_amdgcn_update_dpp(0, __float_as_int(v), CTRL, RMASK, 0xf, false)); }
DI float wave_incl_scan(float v) {
    v = dpp_add<0x111, 0xf>(v); v = dpp_add<0x112, 0xf>(v); v = dpp_add<0x114, 0xf>(v); v = dpp_add<0x118, 0xf>(v);
    v = dpp_add<0x142, 0xa>(v); v = dpp_add<0x143, 0xc>(v);
    return v;
}
template <int CTRL> DI float dpp_perm_add(float v) { return v + __int_as_float(__builtin_amdgcn_update_dpp(0, __float_as_int(v), CTRL, 0xf, 0xf, true)); }
DI float quad_sum(float v) { v = dpp_perm_add<0xB1>(v); return dpp_perm_add<0x4E>(v); }
DI float row16_sum(float v) { v = quad_sum(v); v = dpp_perm_add<0x141>(v); return dpp_perm_add<0x140>(v); }
#ifndef WGM_VAL
#define WGM_VAL 4
#endif
constexpr int BM = 256, BK = 64, HALF = 128, HTB = HALF * BK * 2, STAGE_BYTES = 8 * HTB, NXCD = 8, WGM = WGM_VAL;
DI int lds_byte(int r, int c) { const int st = (r >> 4) * 2 + (c >> 5), rr = r & 15, cc = c & 31, ob = rr * 64 + cc * 2; return st * 1024 + (ob ^ (((ob >> 9) & 1) << 5)); }
DI void stage_rc(int b, int& R, int& C) { const int st = b / 1024, sb = b % 1024, swz = sb ^ (((sb >> 9) & 1) << 5); R = (st >> 1) * 16 + swz / 64; C = (st & 1) * 32 + (swz % 64) / 2; }
DI int perm32(int rho) { const int n = rho >> 4, i = rho & 15; return 8 * (i >> 2) + 4 * n + (i & 3); }

struct Unit { int pm, pn, g, ks, rot; const char* a; const char* b; };
#ifndef USE_KROT
#define KROT(x) 0
#else
#define KROT(x) (((x) & 1) ? (((K / BK) >> 1) & ~1) : 0)
#endif
struct Sched {
    int nM, nN, nwg, G, c, ng, K, ld, tail, pm0, nsplit;
    const char* A0; const char* B0; size_t ags, bgs;
    DI void init(int nM_, int nN_, int K_, const void* A, const void* B, int ng_ = 1, size_t ags_ = 0, size_t bgs_ = 0) {
        nM = nM_; nN = nN_; nwg = nM * nN; G = (int)gridDim.x; c = (int)blockIdx.x; ng = ng_; K = K_; ld = K_; tail = 0; pm0 = 0; nsplit = 1; A0 = (const char*)A; B0 = (const char*)B; ags = ags_; bgs = bgs_; }
    DI void init_tail(int pm0_, int nM_, int nN_, int Ksub, int nsplit_, int ld_, const void* A, const void* B) {
        nM = nM_; nN = nN_; nwg = nM * nN * nsplit_; G = (int)gridDim.x; c = (int)blockIdx.x; ng = 1; K = Ksub; ld = ld_; tail = 1; pm0 = pm0_; nsplit = nsplit_; A0 = (const char*)A; B0 = (const char*)B; ags = 0; bgs = 0; }
    DI void init_cm(int pm0_, int nM_, int nN_, int K_, const void* A, const void* B, size_t ags_, size_t bgs_) {
        nM = nM_; nN = nN_; nwg = nM * nN * 3; G = (int)gridDim.x; c = (int)blockIdx.x; ng = 1; K = K_; ld = K_; tail = 2; pm0 = pm0_; nsplit = 1; A0 = (const char*)A; B0 = (const char*)B; ags = ags_; bgs = bgs_; }
    DI bool next(int i, Unit& u) const {
        const size_t tstep = (size_t)BM * ld * 2;
        if (tail == 2) {
            const long L = (long)i * G + c; if (L >= nwg) return false;
            const int g = (int)L % 3, u2 = (int)L / 3;
            u.pm = pm0 + u2 % nM; u.pn = u2 / nM; u.g = g; u.ks = 0; u.rot = 0;
            u.a = A0 + (size_t)g * ags + (size_t)u.pm * tstep; u.b = B0 + (size_t)g * bgs + (size_t)u.pn * tstep; return true;
        }
        if (tail) {
            const long L = (long)i * G + c; if (L >= nwg) return false;
            const int ks = (int)L % nsplit, u2 = (int)L / nsplit;
            u.pm = pm0 + u2 % nM; u.pn = u2 / nM; u.g = 0; u.ks = ks;
            u.rot = KROT(u.pm + u.pn);
            u.a = A0 + (size_t)u.pm * tstep + (size_t)ks * K * 2; u.b = B0 + (size_t)u.pn * tstep + (size_t)ks * K * 2; return true;
        }
        const int round = i / ng, g = i - round * ng;
        const long L = (long)round * G + c; if (L >= nwg) return false;
        int wgid = (int)L; { const int q = nwg / NXCD, r = nwg % NXCD, xcd = wgid % NXCD, off = wgid / NXCD; wgid = (xcd < r ? xcd * (q + 1) : r * (q + 1) + (xcd - r) * q) + off; }
        const int nig = WGM * nN, gid = wgid / nig, fm = gid * WGM, gsz = (nM - fm) < WGM ? (nM - fm) : WGM;
        u.pm = fm + ((wgid % nig) % gsz); u.pn = (wgid % nig) / gsz; u.g = g; u.ks = 0;
        u.rot = KROT(u.pm + u.pn);
        u.a = A0 + (size_t)g * ags + (size_t)u.pm * tstep; u.b = B0 + (size_t)g * bgs + (size_t)u.pn * tstep; return true;
    }
};

template <class Epi>
DI void gemm_phase(LAS uchar* lds, const Sched& S, const Epi& E) {
    const int tid = otid(), wid = __builtin_amdgcn_readfirstlane(tid >> 6), lane = tid & 63, wr = wid >> 2, wc = wid & 3, fr = lane & 15, fq = lane >> 4;
    const int K = S.ld, nt = S.K / BK;
#ifdef GEMM_STAGGER
    { const int sg = (blockIdx.x >> 3) & 3; for (int q = 0; q < sg; ++q) __builtin_amdgcn_s_sleep(64); }
#endif
#define PG8_LAS LAS
    unsigned voffA[2], voffB[2];
#pragma unroll
    for (int i = 0; i < 2; ++i) { int R, C; stage_rc(tid * 16 + i * 8192, R, C); const int Rb = Epi::PERM ? ((R & ~31) + perm32(R & 31)) : R;
        voffA[i] = (unsigned)(R * K + C) * 2u; voffB[i] = (unsigned)(Rb * K + C) * 2u; }
    const size_t kstep = (size_t)(BK * 2);
    const size_t hstep = (size_t)HALF * K * 2;

    const unsigned ldsw = (unsigned)wid * 1024u;
    const int aoff = lds_byte(wr * 64 + fr, fq * 8), boff = lds_byte(wc * 32 + fr, fq * 8);
#define PG8_SA(b, h) (((b) * 2 + (h)) * HTB)
#define PG8_SB(b, h) ((4 + (b) * 2 + (h)) * HTB)
#define PG8_STAGE(bufoff, gbase, voff) do { _Pragma("unroll") for (int _i = 0; _i < 2; ++_i) \
        __builtin_amdgcn_global_load_lds((const unsigned*)((const char*)(gbase) + (voff)[_i]), (PG8_LAS unsigned*)(lds + (bufoff) + ldsw + _i * 8192), 16, 0, 0); } while (0)
#define PG8_LDA(dst, b, h) do { _Pragma("unroll") for (int m = 0; m < 4; ++m) _Pragma("unroll") for (int k = 0; k < 2; ++k) dst[m][k] = *(const PG8_LAS bf16x8*)(lds + PG8_SA(b, h) + aoff + m * 2048 + k * 1024); } while (0)
#define PG8_LDB(dst, b, h) do { _Pragma("unroll") for (int n = 0; n < 2; ++n) _Pragma("unroll") for (int k = 0; k < 2; ++k) dst[n][k] = *(const PG8_LAS bf16x8*)(lds + PG8_SB(b, h) + boff + n * 2048 + k * 1024); } while (0)
#define PG8_MMA(ai, bj, At, Bt) do { __builtin_amdgcn_s_setprio(1); _Pragma("unroll") for (int m = 0; m < 4; ++m) _Pragma("unroll") for (int n = 0; n < 2; ++n) _Pragma("unroll") for (int k = 0; k < 2; ++k) \
        acc[ai][bj][m][n] = __builtin_amdgcn_mfma_f32_16x16x32_bf16(Bt[n][k], At[m][k], acc[ai][bj][m][n], 0, 0, 0); __builtin_amdgcn_s_setprio(0); } while (0)
#define PG8_WAIT_V(n) asm volatile("s_waitcnt vmcnt(" #n ")" ::: "memory")
#define PG8_WAIT_L(n) asm volatile("s_waitcnt lgkmcnt(" #n ")" ::: "memory")
#define PG8_BAR __builtin_amdgcn_s_barrier()
#define PG8_SCHED __builtin_amdgcn_sched_barrier(0)
    Unit cur, nxt; int ui = 0;
    if (!S.next(0, cur)) return;
    f32x4 acc[2][2][4][2];
#pragma unroll
    for (int a = 0; a < 2; ++a)
#pragma unroll
        for (int b = 0; b < 2; ++b)
#pragma unroll
            for (int m = 0; m < 4; ++m)
#pragma unroll
                for (int n = 0; n < 2; ++n) acc[a][b][m][n] = (f32x4){0.f, 0.f, 0.f, 0.f};
    bf16x8 At[4][2], B0[2][2], B1[2][2];
    const char* cA = cur.a; const char* cB = cur.b;
    int rc = cur.rot;
    const size_t r0off = (size_t)rc * kstep;

    PG8_STAGE(PG8_SB(0, 0), cB + r0off, voffB); PG8_STAGE(PG8_SA(0, 0), cA + r0off, voffA); PG8_STAGE(PG8_SB(0, 1), cB + r0off + hstep, voffB); PG8_STAGE(PG8_SA(0, 1), cA + r0off + hstep, voffA);
    if (wr == 1) PG8_BAR;
    PG8_WAIT_V(4); PG8_BAR;
    PG8_STAGE(PG8_SB(1, 0), cB + r0off + kstep, voffB); PG8_STAGE(PG8_SA(1, 0), cA + r0off + kstep, voffA); PG8_STAGE(PG8_SB(1, 1), cB + r0off + hstep + kstep, voffB);
    PG8_WAIT_V(6); PG8_BAR;
    for (;;) {
        const bool has_next = S.next(ui + 1, nxt);
        const char* nA = has_next ? nxt.a : cA; const char* nB = has_next ? nxt.b : cB; const int rn = has_next ? nxt.rot : rc;
        for (int t = 0; t < nt; t += 2) {
            const bool last = (t == nt - 2);
            int t1 = t + rc; t1 = t1 >= nt ? t1 - nt : t1; int t2 = t + 2 + rc; t2 = t2 >= nt ? t2 - nt : t2;
            const char* a1 = cA + (size_t)(t1 + 1) * kstep;
            const char* a2 = last ? nA + (size_t)rn * kstep : cA + (size_t)t2 * kstep; const char* b2 = last ? nB + (size_t)rn * kstep : cB + (size_t)t2 * kstep;
            const char* a3 = a2 + kstep; const char* b3 = b2 + kstep;

            PG8_LDB(B0, 0, 0); PG8_SCHED; PG8_LDA(At, 0, 0); PG8_STAGE(PG8_SA(1, 1), a1 + hstep, voffA);
            PG8_WAIT_L(8); PG8_BAR; PG8_WAIT_L(0); PG8_MMA(0, 0, At, B0); PG8_BAR; PG8_SCHED;
            PG8_LDB(B1, 0, 1); PG8_STAGE(PG8_SB(0, 0), b2, voffB);
            PG8_BAR; PG8_WAIT_L(0); PG8_MMA(0, 1, At, B1); PG8_BAR;
            PG8_LDA(At, 0, 1); PG8_STAGE(PG8_SA(0, 0), a2, voffA);
            PG8_BAR; PG8_WAIT_L(0); PG8_MMA(1, 0, At, B0); PG8_BAR; PG8_SCHED;
            PG8_STAGE(PG8_SB(0, 1), b2 + hstep, voffB);
            PG8_WAIT_V(6); PG8_BAR; PG8_MMA(1, 1, At, B1); PG8_BAR;
            PG8_LDB(B0, 1, 0); PG8_SCHED; PG8_LDA(At, 1, 0); PG8_STAGE(PG8_SA(0, 1), a2 + hstep, voffA);
            PG8_WAIT_L(8); PG8_BAR; PG8_WAIT_L(0); PG8_MMA(0, 0, At, B0); PG8_BAR; PG8_SCHED;
            PG8_LDB(B1, 1, 1); PG8_STAGE(PG8_SB(1, 0), b3, voffB);
            PG8_BAR; PG8_WAIT_L(0); PG8_MMA(0, 1, At, B1); PG8_BAR;
            PG8_LDA(At, 1, 1); PG8_STAGE(PG8_SA(1, 0), a3, voffA);
            PG8_BAR; PG8_WAIT_L(0); PG8_MMA(1, 0, At, B0); PG8_BAR; PG8_SCHED;
            PG8_STAGE(PG8_SB(1, 1), b3 + hstep, voffB);
            PG8_WAIT_V(6); PG8_BAR; PG8_MMA(1, 1, At, B1); PG8_BAR;
        }
        E(acc, cur, wr, wc, fr, fq);
#ifdef PROBE_EPI2
        if constexpr (Epi::IDEM) E(acc, cur, wr, wc, fr, fq);
#endif
        if (!has_next) break;
        if (!(Epi::CHAIN && nxt.g != 0))
#pragma unroll
        for (int a = 0; a < 2; ++a)
#pragma unroll
            for (int b = 0; b < 2; ++b)
#pragma unroll
                for (int m = 0; m < 4; ++m)
#pragma unroll
                    for (int n = 0; n < 2; ++n) acc[a][b][m][n] = (f32x4){0.f, 0.f, 0.f, 0.f};
        cur = nxt; cA = nA; cB = nB; rc = rn; ++ui;
    }
    PG8_WAIT_V(0);
    if (wr == 0) PG8_BAR;
    PG8_BAR;


#undef PG8_SA
#undef PG8_SB
#undef PG8_STAGE
#undef PG8_LDA
#undef PG8_LDB
#undef PG8_MMA
#undef PG8_WAIT_V
#undef PG8_WAIT_L
#undef PG8_BAR
#undef PG8_SCHED
}

DI int panel_grow(int pm, int hf) { return hf < 0 ? pm * 256 : (pm < 64 ? hf * HLAT + pm * 256 : NLAT + hf * HCTX + (pm - 64) * 256); }

struct EpiSwiGLU {
    static constexpr bool PERM = true, IDEM = true, CHAIN = false; static constexpr int NVM = 6;
    bf16_t* H;
    DI void operator()(const f32x4 (&acc)[2][2][4][2], const Unit& u, int wr, int wc, int fr, int fq) const {
        const int row0 = u.pm * BM + wr * 64 + fr, col0 = u.pn * 128 + wc * 32 + 8 * fq;
#pragma unroll
        for (int ai = 0; ai < 2; ++ai)
#pragma unroll
            for (int m = 0; m < 4; ++m) {
                bf16_t* rowp = H + (size_t)(row0 + ai * HALF + m * 16) * DFF + col0;
                const f32x4 a0 = acc[ai][0][m][0], a1 = acc[ai][0][m][1], b0 = acc[ai][1][m][0], b1 = acc[ai][1][m][1];
                u32x4 w;
                w.x = pk2(siluf_(a0[0]) * b0[0], siluf_(a0[1]) * b0[1]); w.y = pk2(siluf_(a0[2]) * b0[2], siluf_(a0[3]) * b0[3]);
                w.z = pk2(siluf_(a1[0]) * b1[0], siluf_(a1[1]) * b1[1]); w.w = pk2(siluf_(a1[2]) * b1[2], siluf_(a1[3]) * b1[3]);
                *(u32x4*)rowp = w;
            }
    }
};
struct EpiResid {
    static constexpr bool PERM = false, IDEM = false, CHAIN = false; static constexpr int NVM = 24;
    const float* in_lat; const float* in_ctx; float* out_lat; float* out_ctx; const float* mod; int mrow; float coef; int hf;
    DI void operator()(const f32x4 (&acc)[2][2][4][2], const Unit& u, int wr, int wc, int fr, int fq) const {
        const int grow0 = panel_grow(u.pm, hf); const bool isctx = grow0 >= NLAT; const int b = isctx ? 4 : grow0 / SEQ;
        const float* mp = mod + (size_t)b * (NMOD * D) + mrow * D;
        const float* ib = isctx ? in_ctx + (size_t)(grow0 - NLAT) * D : in_lat + (size_t)grow0 * D;
        float* ob = isctx ? out_ctx + (size_t)(grow0 - NLAT) * D : out_lat + (size_t)grow0 * D;
        const int r0 = wr * 64 + fr, c0 = u.pn * BM + wc * 32 + 4 * fq;
        f32x4 gv[2][2];
#pragma unroll
        for (int bj = 0; bj < 2; ++bj)
#pragma unroll
            for (int n = 0; n < 2; ++n) gv[bj][n] = *(const f32x4*)(mp + c0 + bj * HALF + n * 16) * coef;
#pragma unroll
        for (int ai = 0; ai < 2; ++ai)
#pragma unroll
            for (int mp = 0; mp < 2; ++mp) {
                f32x4 xi[2][2][2];
#pragma unroll
                for (int mm = 0; mm < 2; ++mm)
#pragma unroll
                    for (int bj = 0; bj < 2; ++bj)
#pragma unroll
                        for (int n = 0; n < 2; ++n) xi[mm][bj][n] = *(const f32x4*)(ib + (size_t)(r0 + ai * HALF + (2 * mp + mm) * 16) * D + c0 + bj * HALF + n * 16);
#pragma unroll
                for (int mm = 0; mm < 2; ++mm)
#pragma unroll
                    for (int bj = 0; bj < 2; ++bj)
#pragma unroll
                        for (int n = 0; n < 2; ++n)
                            *(f32x4*)(ob + (size_t)(r0 + ai * HALF + (2 * mp + mm) * 16) * D + c0 + bj * HALF + n * 16) = xi[mm][bj][n] + gv[bj][n] * acc[ai][bj][2 * mp + mm][n];
            }
    }
};
struct EpiPartial {
    static constexpr bool PERM = false, IDEM = false, CHAIN = false; static constexpr int NVM = 24;
    float* part; const float* mod; int mrow; float coef; int pm0, grp, nsplit, rpg;
    DI void operator()(const f32x4 (&acc)[2][2][4][2], const Unit& u, int wr, int wc, int fr, int fq) const {
        const float* mp = mod + (size_t)4 * (NMOD * D) + mrow * D;
        float* ob = part + ((size_t)(grp * nsplit + u.ks) * rpg + (size_t)(u.pm - pm0) * BM) * D;
        const int r0 = wr * 64 + fr, c0 = u.pn * BM + wc * 32 + 4 * fq;
        f32x4 gv[2][2];
#pragma unroll
        for (int bj = 0; bj < 2; ++bj)
#pragma unroll
            for (int n = 0; n < 2; ++n) gv[bj][n] = *(const f32x4*)(mp + c0 + bj * HALF + n * 16) * coef;
#pragma unroll
        for (int ai = 0; ai < 2; ++ai)
#pragma unroll
            for (int m = 0; m < 4; ++m)
#pragma unroll
                for (int bj = 0; bj < 2; ++bj)
#pragma unroll
                    for (int n = 0; n < 2; ++n)
                        *(f32x4*)(ob + (size_t)(r0 + ai * HALF + m * 16) * D + c0 + bj * HALF + n * 16) = gv[bj][n] * acc[ai][bj][m][n];
    }
};
struct EpiZ {
    static constexpr bool PERM = true, IDEM = true, CHAIN = false; static constexpr int NVM = 12;
    bf16_t* Z;
    DI void operator()(const f32x4 (&acc)[2][2][4][2], const Unit& u, int wr, int wc, int fr, int fq) const {
        const int row0 = u.pm * BM + wr * 64 + fr, col0 = u.pn * BM + wc * 32 + 8 * fq; const bool sg = u.pn >= (Z_GATE / BM);
#pragma unroll
        for (int ai = 0; ai < 2; ++ai)
#pragma unroll
            for (int m = 0; m < 4; ++m) {
                bf16_t* rowp = Z + (size_t)(row0 + ai * HALF + m * 16) * ZC + col0;
#pragma unroll
                for (int bj = 0; bj < 2; ++bj) {
                    f32x4 v0 = acc[ai][bj][m][0], v1 = acc[ai][bj][m][1];
                    if (sg) {
#pragma unroll
                        for (int k = 0; k < 4; ++k) { v0[k] = sigmoidf_(v0[k]); v1[k] = sigmoidf_(v1[k]); } }
                    u32x4 w; w.x = pk2(v0[0], v0[1]); w.y = pk2(v0[2], v0[3]); w.z = pk2(v1[0], v1[1]); w.w = pk2(v1[2], v1[3]);
                    *(u32x4*)(rowp + bj * HALF) = w;
                }
            }
    }
};
struct EpiGated {
    static constexpr bool PERM = true, IDEM = false, CHAIN = false; static constexpr int NVM = 24;
    float* G; const bf16_t* Z; int pm0;
    DI void operator()(const f32x4 (&acc)[2][2][4][2], const Unit& u, int wr, int wc, int fr, int fq) const {
        const int row0 = u.pm * BM + wr * 64 + fr, col0 = u.pn * BM + wc * 32 + 8 * fq;
#pragma unroll
        for (int ai = 0; ai < 2; ++ai) {
            u32x4 gw[4][2];
#pragma unroll
            for (int m = 0; m < 4; ++m)
#pragma unroll
                for (int bj = 0; bj < 2; ++bj) gw[m][bj] = *(const u32x4*)(Z + (size_t)(row0 + ai * HALF + m * 16) * ZC + Z_GATE + u.g * D + col0 + bj * HALF);
#pragma unroll
            for (int m = 0; m < 4; ++m)
#pragma unroll
                for (int bj = 0; bj < 2; ++bj) {
                    float gf[8]; unpack8(gw[m][bj], gf);
                    const f32x4 v0 = acc[ai][bj][m][0], v1 = acc[ai][bj][m][1];
                    float* gp = G + ((size_t)u.g * HCTX + (size_t)(row0 - pm0 * BM + ai * HALF + m * 16)) * D + col0 + bj * HALF;
                    *(f32x4*)gp = (f32x4){gf[0] * v0[0], gf[1] * v0[1], gf[2] * v0[2], gf[3] * v0[3]};
                    *(f32x4*)(gp + 4) = (f32x4){gf[4] * v1[0], gf[5] * v1[1], gf[6] * v1[2], gf[7] * v1[3]};
                }
        }
    }
};
struct EpiMerge {
    static constexpr bool PERM = true, IDEM = false, CHAIN = false; static constexpr int NVM = 24;
    bf16_t* Y; const bf16_t* Z;
    DI void operator()(const f32x4 (&acc)[2][2][4][2], const Unit& u, int wr, int wc, int fr, int fq) const {
        const int row0 = u.pm * BM + wr * 64 + fr, col0 = u.pn * BM + wc * 32 + 8 * fq;
#pragma unroll
        for (int ai = 0; ai < 2; ++ai) {
            u32x4 gw[4][2], yw[4][2];
#pragma unroll
            for (int m = 0; m < 4; ++m)
#pragma unroll
                for (int bj = 0; bj < 2; ++bj) {
                    const size_t row = (size_t)(row0 + ai * HALF + m * 16);
                    gw[m][bj] = *(const u32x4*)(Z + row * ZC + Z_GATE + u.g * D + col0 + bj * HALF);
                    yw[m][bj] = u.g ? *(const u32x4*)(Y + row * D + col0 + bj * HALF) : (u32x4){0u, 0u, 0u, 0u};
                }
#pragma unroll
            for (int m = 0; m < 4; ++m)
#pragma unroll
                for (int bj = 0; bj < 2; ++bj) {
                    const size_t row = (size_t)(row0 + ai * HALF + m * 16);
                    float gf[8], yf[8]; unpack8(gw[m][bj], gf); unpack8(yw[m][bj], yf);
                    const f32x4 v0 = acc[ai][bj][m][0], v1 = acc[ai][bj][m][1];
#pragma unroll
                    for (int k = 0; k < 4; ++k) { yf[k] += gf[k] * v0[k]; yf[4 + k] += gf[4 + k] * v1[k]; }
                    *(u32x4*)(Y + row * D + col0 + bj * HALF) = pack8(yf);
                }
        }
    }
};

DI float wave_sum(float v) {
    v = row16_sum(v);
    const int iv = __float_as_int(v);
    return (__int_as_float(__builtin_amdgcn_readlane(iv, 0)) + __int_as_float(__builtin_amdgcn_readlane(iv, 16))) + (__int_as_float(__builtin_amdgcn_readlane(iv, 32)) + __int_as_float(__builtin_amdgcn_readlane(iv, 48)));
}

DI int wsrc(int np, int mode) {
    if (mode == 1) { const int pn = np >> 8, bj = (np >> 7) & 1, cc = np & 127; return bj * DFF + pn * 128 + cc; }
    if (mode == 2) return np < DIN_MIX ? np : (np < Z_GATE ? -1 : np - (Z_GATE - DIN_MIX));
    return np;
}
DI void conv_tile(LAS uchar* lds, const float* W, int K, int N, bf16_t* WT, int NP, int mode, int item) {
    LAS float* tile = (LAS float*)lds;
    const int ntn = NP / 128, kb = item / ntn, nb = item % ntn, k0 = kb * 64, n0 = nb * 128, tid = otid();
    { const int nl = tid & 127, kr0 = tid >> 7; const int src = wsrc(n0 + nl, mode);
      const int srcc = src >= 0 ? src : 0; const float vsel = src >= 0 ? 1.f : 0.f; float wv[16];
#pragma unroll
      for (int i = 0; i < 16; ++i) wv[i] = W[(size_t)(k0 + kr0 + 4 * i) * N + srcc];
#pragma unroll
      for (int i = 0; i < 16; ++i) tile[(kr0 + 4 * i) * 129 + nl] = wv[i] * vsel; }
    block_sync();
    { const int nl = tid >> 2, ks = (tid & 3) * 16; float f[8], g[8];
#pragma unroll
      for (int j = 0; j < 8; ++j) { f[j] = tile[(ks + j) * 129 + nl]; g[j] = tile[(ks + 8 + j) * 129 + nl]; }
      bf16_t* dst = WT + (size_t)(n0 + nl) * K + k0 + ks;
      *(u32x4*)dst = pack8(f); *(u32x4*)(dst + 8) = pack8(g); }
    block_sync();
}
DI void phase_convert(LAS uchar* lds, const Params& P, int layer) {
    bf16_t* WT = (bf16_t*)(P.ws + WS_WT);
    constexpr int I13 = (D / 64) * (2 * DFF / 128), I2 = (DFF / 64) * (D / 128), IIN = (D / 64) * (ZC / 128), IOUT = (512 / 64) * (D / 128), IO = (D / 64) * (D / 128);
    constexpr int NIT = 2 * I13 + 2 * I2 + IIN + 3 * IOUT + IO;
    for (int it = blockIdx.x; it < NIT; it += gridDim.x) {
        int r = it;
        if (r < I13) { conv_tile(lds, P.in[I_F1W13] + (size_t)layer * D * 2 * DFF, D, 2 * DFF, WT + WT_W13A, 2 * DFF, 1, r); continue; } r -= I13;
        if (r < I13) { conv_tile(lds, P.in[I_F2W13] + (size_t)layer * D * 2 * DFF, D, 2 * DFF, WT + WT_W13B, 2 * DFF, 1, r); continue; } r -= I13;
        if (r < I2) { conv_tile(lds, P.in[I_F1W2] + (size_t)layer * DFF * D, DFF, D, WT + WT_W2A, D, 0, r); continue; } r -= I2;
        if (r < I2) { conv_tile(lds, P.in[I_F2W2] + (size_t)layer * DFF * D, DFF, D, WT + WT_W2B, D, 0, r); continue; } r -= I2;
        if (r < IIN) { conv_tile(lds, P.in[I_WIN] + (size_t)layer * D * DIN, D, DIN, WT + WT_WIN, ZC, 2, r); continue; } r -= IIN;
        if (r < IOUT) { conv_tile(lds, P.in[I_WOA] + (size_t)layer * 512 * D, 512, D, WT + WT_WOUT, D, 0, r); continue; } r -= IOUT;
        if (r < IOUT) { conv_tile(lds, P.in[I_WOG] + (size_t)layer * 512 * D, 512, D, WT + WT_WOUT + (size_t)D * 512, D, 0, r); continue; } r -= IOUT;
        if (r < IOUT) { conv_tile(lds, P.in[I_WOM] + (size_t)layer * 512 * D, 512, D, WT + WT_WOUT + (size_t)2 * D * 512, D, 0, r); continue; } r -= IOUT;
        conv_tile(lds, P.in[I_WO] + (size_t)layer * D * D, D, D, WT + WT_WO, D, 0, r);
    }
}

DI void phase_mods(LAS uchar* lds, const Params& P) {
    LAS float* sc = (LAS float*)lds;
    LAS float* red = sc + 5 * D;
    const int tid = otid();
    for (int idx = tid; idx < 5 * D; idx += 512) { const int r = idx >> 10, k = idx & 1023; const float v = r < 4 ? P.in[I_C][r * D + k] : P.in[I_CCTX][k]; sc[idx] = siluf_(v); }
    block_sync();
    float* MOD = (float*)(P.ws + WS_MOD);
    const int col = tid & 63, kq = tid >> 6;
    for (int it = blockIdx.x; it < 2 * 144; it += gridDim.x) {
        const int l = it / 144, cb = it % 144;
        const float* w = P.in[I_MODW] + (size_t)l * D * (NMOD * D) + cb * 64 + col;
        float a0 = 0.f, a1 = 0.f, a2 = 0.f, a3 = 0.f, a4 = 0.f;
#pragma unroll 16
        for (int k = kq * 128; k < kq * 128 + 128; ++k) { const float wv = w[(size_t)k * (NMOD * D)]; a0 += sc[k] * wv; a1 += sc[D + k] * wv; a2 += sc[2 * D + k] * wv; a3 += sc[3 * D + k] * wv; a4 += sc[4 * D + k] * wv; }
        red[(kq * 5 + 0) * 64 + col] = a0; red[(kq * 5 + 1) * 64 + col] = a1; red[(kq * 5 + 2) * 64 + col] = a2; red[(kq * 5 + 3) * 64 + col] = a3; red[(kq * 5 + 4) * 64 + col] = a4;
        block_sync();
        if (tid < 320) { const int r = tid >> 6; float s = P.in[I_MODB][(size_t)l * NMOD * D + cb * 64 + col];
#pragma unroll
            for (int q = 0; q < 8; ++q) s += red[(q * 5 + r) * 64 + col];
            MOD[((size_t)l * 5 + r) * (NMOD * D) + cb * 64 + col] = s; }
        block_sync();
    }
}
__device__ const double ROPE_INV[16] = {1.0, 0.5623413251903491, 0.31622776601683794, 0.1778279410038923, 0.1, 0.05623413251903491, 0.031622776601683791, 0.01778279410038923,
                                        0.01, 0.005623413251903491, 0.0031622776601683794, 0.001778279410038923, 0.001, 0.0005623413251903491, 0.00031622776601683794, 0.0001778279410038923};
DI void phase_rope(const Params& P) {
    float* tab = (float*)(P.ws + WS_ROPE);
    for (int idx = blockIdx.x * 512 + otid(); idx < 128 * 16; idx += gridDim.x * 512) {
        const int p = idx >> 4, f = idx & 15;
        const float inv = (float)ROPE_INV[f]; const float angf = (float)p * inv;
        double rev = (double)angf * 0.15915494309189535; rev -= floor(rev);
        tab[idx * 2] = __builtin_amdgcn_cosf((float)rev); tab[idx * 2 + 1] = __builtin_amdgcn_sinf((float)rev);
    }
}

struct CtxRed { const float* part; int nsplit, rpg; float* xc_wb; };
DI void ctx_reduce_row(const CtxRed& R, int cr, int lane, f32x4 (&v)[4]) {
    const size_t base = ((size_t)(cr / R.rpg) * R.nsplit * R.rpg + (size_t)(cr % R.rpg)) * D;
    for (int ks = 0; ks < R.nsplit; ++ks) {
        const float* pr = R.part + base + (size_t)ks * R.rpg * D;
#pragma unroll
        for (int q = 0; q < 4; ++q) v[q] += *(const f32x4*)(pr + q * 256 + lane * 4);
    }
#pragma unroll
    for (int q = 0; q < 4; ++q) *(f32x4*)(R.xc_wb + (size_t)cr * D + q * 256 + lane * 4) = v[q];
}
DI void phase_adaln(const Params& P, int layer, int j, const float* src_lat, const float* src_ctx, bf16_t* dst, int nrows, int hf, const CtxRed red, int extra_lo, int extra_hi) {
    const int tid = otid(), lane = tid & 63, wave = tid >> 6;
    const float* MOD = (const float*)(P.ws + WS_MOD) + (size_t)layer * 5 * NMOD * D;
    const float* gain = P.in[I_NORMG] + ((size_t)layer * 3 + j) * D;
    const int stride = gridDim.x * 8;
    auto grow_of = [&](int lr) -> int { return hf < 0 ? lr : (lr < HLAT ? hf * HLAT + lr : NLAT + hf * HCTX + (lr - HLAT)); };
    auto xrow_of = [&](int gr) -> const float* { return gr < NLAT ? src_lat + (size_t)gr * D : src_ctx + (size_t)(gr - NLAT) * D; };
    int lr = blockIdx.x * 8 + wave;
    f32x4 vn[4];
    if (lr < nrows) { const float* xr = xrow_of(grow_of(lr));
#pragma unroll
        for (int q = 0; q < 4; ++q) vn[q] = *(const f32x4*)(xr + q * 256 + lane * 4); }
    f32x4 gq[4], s0q[4], s1q[4]; int bcur = -1;
#pragma unroll
    for (int q = 0; q < 4; ++q) gq[q] = *(const f32x4*)(gain + q * 256 + lane * 4);
    for (; lr < nrows; lr += stride) {
        const int gr = grow_of(lr);
        const int b = gr < NLAT ? gr / SEQ : 4;
        if (b != bcur) {
            const float* sh = MOD + (size_t)b * NMOD * D + (3 * j) * D; const float* scl = sh + D;
#pragma unroll
            for (int q = 0; q < 4; ++q) { s0q[q] = *(const f32x4*)(sh + q * 256 + lane * 4); s1q[q] = *(const f32x4*)(scl + q * 256 + lane * 4) + 1.f; }
            bcur = b;
        }
        f32x4 v[4]; float ss = 0.f;
#pragma unroll
        for (int q = 0; q < 4; ++q) v[q] = vn[q];
        if (lr + stride < nrows) { const float* xr = xrow_of(grow_of(lr + stride));
#pragma unroll
            for (int q = 0; q < 4; ++q) vn[q] = *(const f32x4*)(xr + q * 256 + lane * 4); }
        if (red.part != nullptr && gr >= NLAT) ctx_reduce_row(red, gr - NLAT, lane, v);
#pragma unroll
        for (int q = 0; q < 4; ++q) ss += v[q][0] * v[q][0] + v[q][1] * v[q][1] + v[q][2] * v[q][2] + v[q][3] * v[q][3];
        ss = wave_sum(ss);
        const float rstd = rsqrtf(ss * (1.f / D) + 1e-6f);
#pragma unroll
        for (int q = 0; q < 4; ++q) {
            const int c = q * 256 + lane * 4;
            const f32x4 y = v[q] * rstd * gq[q] * s1q[q] + s0q[q];
            u32x2 w; w.x = pk2(y[0], y[1]); w.y = pk2(y[2], y[3]);
            *(u32x2*)(dst + (size_t)lr * D + c) = w;
        }
    }
    if (red.part != nullptr)
        for (int cr = extra_lo + blockIdx.x * 8 + wave; cr < extra_hi; cr += gridDim.x * 8) {
            f32x4 v[4];
#pragma unroll
            for (int q = 0; q < 4; ++q) v[q] = *(const f32x4*)(src_ctx + (size_t)cr * D + q * 256 + lane * 4);
            ctx_reduce_row(red, cr, lane, v);
        }
}

constexpr int KS_STRIDE = 144, VT_STRIDE = 264, AT_KS = 0, AT_VT = 128 * KS_STRIDE;
DI void attn_item(LAS uchar* lds, const Params& P, int layer, const bf16_t* z, bf16_t* aout, int item) {
    const int tid = otid(), wave = __builtin_amdgcn_readfirstlane(tid >> 6), lane = tid & 63, r = lane & 31, hh = lane >> 5;
    const bool isctx = item >= 256;
    int lb, kvh, nb;
    if (!isctx) { lb = item >> 7; kvh = (item >> 6) & 1; nb = item & 63; } else { const int it = item - 256; lb = it >> 2; kvh = (it >> 1) & 1; nb = it & 1; }
    const int qbase = isctx ? HLAT + lb * CTXL + nb * 128 : lb * SEQ + nb * 128;
    const int g = wave >> 1, hq = kvh * 4 + g, qi0 = (wave & 1) * 64;
    const float* rope = (const float*)(P.ws + WS_ROPE);
    const float* qn = P.in[I_AQN] + layer * 64; const float* kn = P.in[I_AKN] + layer * 64;
    const float sink2 = P.in[I_SINK][layer * 8 + hq] * 1.4426950408889634f;
    LAS uchar* Ks = lds + AT_KS; LAS uchar* Vt = lds + AT_VT;

    auto kb_valid = [&](int kb) -> bool { if (kb >= 3) return kb < 5; if (isctx) return false; const int kblk = nb + kb - 1; return kblk >= 0 && kblk < SEQ / 128; };
    auto kb_row0 = [&](int kb) -> int { return kb >= 3 ? HLAT + lb * CTXL + (kb - 3) * 128 : lb * SEQ + (nb + kb - 1) * 128; };
    const int key = tid >> 2, dq = tid & 3;
    u32x4 pk0, pk1, pv0, pv1;
    f32x4 pr0, pr1, pr2, pr3;
    pr0 = pr1 = pr2 = pr3 = (f32x4){1.f, 0.f, 1.f, 0.f};
#define ATT_LOAD(kb_) do { const bf16_t* zr_ = z + (size_t)(kb_row0(kb_) + key) * ZC; \
        pk0 = *(const u32x4*)(zr_ + Z_AK + kvh * 64 + dq * 8); pk1 = *(const u32x4*)(zr_ + Z_AK + kvh * 64 + 32 + dq * 8); \
        pv0 = *(const u32x4*)(zr_ + Z_AV + kvh * 64 + dq * 16); pv1 = *(const u32x4*)(zr_ + Z_AV + kvh * 64 + dq * 16 + 8); \
        if ((kb_) < 3) { const int pos_ = (nb + (kb_) - 1) * 128 + key; const float* tp_ = rope + ((size_t)((dq < 2 ? (pos_ >> 6) : (pos_ & 63)) * 16 + (dq & 1) * 8)) * 2; \
            pr0 = *(const f32x4*)tp_; pr1 = *(const f32x4*)(tp_ + 4); pr2 = *(const f32x4*)(tp_ + 8); pr3 = *(const f32x4*)(tp_ + 12); } } while (0)
    int kb = 0; while (!kb_valid(kb)) ++kb;
    ATT_LOAD(kb);
    float kn1[8], kn2[8];
#pragma unroll
    for (int j = 0; j < 8; ++j) { kn1[j] = kn[dq * 8 + j]; kn2[j] = kn[32 + dq * 8 + j]; }

    bf16x8 Qf[2][4];
#pragma unroll
    for (int qt = 0; qt < 2; ++qt) {
        const int qi = qi0 + qt * 32 + r; const bf16_t* qp = z + (size_t)(qbase + qi) * ZC + Z_AQ + hq * 64 + 8 * hh;
        float f[4][8]; float ss = 0.f;
#pragma unroll
        for (int s = 0; s < 4; ++s) { unpack8(*(const u32x4*)(qp + 16 * s), f[s]);
#pragma unroll
            for (int j = 0; j < 8; ++j) ss += f[s][j] * f[s][j]; }
        ss = xsum32(ss);
        const float rstd = rsqrtf(ss * (1.f / 64.f) + 1e-6f);
#pragma unroll
        for (int s = 0; s < 4; ++s)
#pragma unroll
            for (int j = 0; j < 8; ++j) f[s][j] *= rstd * qn[16 * s + 8 * hh + j];
        if (!isctx) {
            const int pos = nb * 128 + qi;
#pragma unroll
            for (int s = 0; s < 2; ++s) {
                const float* tp = rope + ((size_t)((s == 0 ? (pos >> 6) : (pos & 63)) * 16 + 8 * hh)) * 2;
#pragma unroll
                for (int j = 0; j < 8; ++j) { const float c = tp[2 * j], sn = tp[2 * j + 1], x1 = f[s][j], x2 = f[s + 2][j]; f[s][j] = x1 * c - x2 * sn; f[s + 2][j] = x1 * sn + x2 * c; }
            }
        }
#pragma unroll
        for (int s = 0; s < 4; ++s) {
#pragma unroll
            for (int j = 0; j < 8; ++j) f[s][j] *= 0.125f * 1.4426950408889634f;
            Qf[qt][s] = __builtin_bit_cast(bf16x8, pack8(f[s])); }
    }
    f32x16 O[2][2]; float mrun[2], lrun[2];
#pragma unroll
    for (int qt = 0; qt < 2; ++qt) { O[qt][0] = zero16(); O[qt][1] = zero16(); mrun[qt] = sink2; lrun[qt] = 1.f; }

    while (kb < 5) {
        const bool kctx = kb >= 3;
        block_sync();
        {
            float x1[8], x2[8]; unpack8(pk0, x1); unpack8(pk1, x2);
            float ss = 0.f;
#pragma unroll
            for (int j = 0; j < 8; ++j) ss += x1[j] * x1[j] + x2[j] * x2[j];
            ss = quad_sum(ss);
            const float rstd = rsqrtf(ss * (1.f / 64.f) + 1e-6f);
#pragma unroll
            for (int j = 0; j < 8; ++j) { x1[j] *= rstd * kn1[j]; x2[j] *= rstd * kn2[j]; }
            if (!kctx) {
                const float cs[16] = {pr0[0], pr0[1], pr0[2], pr0[3], pr1[0], pr1[1], pr1[2], pr1[3], pr2[0], pr2[1], pr2[2], pr2[3], pr3[0], pr3[1], pr3[2], pr3[3]};
#pragma unroll
                for (int j = 0; j < 8; ++j) { const float c = cs[2 * j], sn = cs[2 * j + 1], a = x1[j], b = x2[j]; x1[j] = a * c - b * sn; x2[j] = a * sn + b * c; }
            }
            *(LAS u32x4*)(Ks + key * KS_STRIDE + dq * 16) = pack8(x1);
            *(LAS u32x4*)(Ks + key * KS_STRIDE + 64 + dq * 16) = pack8(x2);
            const unsigned vw[8] = {pv0.x, pv0.y, pv0.z, pv0.w, pv1.x, pv1.y, pv1.z, pv1.w};
#pragma unroll
            for (int i = 0; i < 8; ++i) {
                *(LAS bf16_t*)(Vt + (dq * 16 + 2 * i) * VT_STRIDE + key * 2) = (bf16_t)(vw[i] & 0xffffu);
                *(LAS bf16_t*)(Vt + (dq * 16 + 2 * i + 1) * VT_STRIDE + key * 2) = (bf16_t)(vw[i] >> 16); }
        }
        int kbn = kb + 1; while (kbn < 5 && !kb_valid(kbn)) ++kbn;
        if (kbn < 5) ATT_LOAD(kbn);
        block_sync();
#pragma unroll 1
        for (int kt = 0; kt < 4; ++kt) {
            const int q32a = (wave & 1) * 2;
            bool skip[2], diag[2];
#pragma unroll
            for (int qt = 0; qt < 2; ++qt) { const int q32 = q32a + qt; skip[qt] = (kb == 0 && kt < q32) || (kb == 2 && kt > q32); diag[qt] = (kb == 0 || kb == 2) && kt == q32; }
            if (skip[0] && skip[1]) continue;
            bf16x8 Kf[4];
#pragma unroll
            for (int s = 0; s < 4; ++s) Kf[s] = lds_frag(Ks + (kt * 32 + r) * KS_STRIDE + (16 * s + 8 * hh) * 2);
            bf16x8 Vf[2][2];
#pragma unroll
            for (int dt = 0; dt < 2; ++dt)
#pragma unroll
                for (int s = 0; s < 2; ++s) {
                    const LAS uchar* vp = Vt + (dt * 32 + r) * VT_STRIDE + (kt * 32 + 16 * s + 4 * hh) * 2;
                    const u32x2 lo = *(const LAS u32x2*)vp, hi = *(const LAS u32x2*)(vp + 16);
                    u32x4 w; w.x = lo.x; w.y = lo.y; w.z = hi.x; w.w = hi.y; Vf[dt][s] = __builtin_bit_cast(bf16x8, w); }
#pragma unroll
            for (int qt = 0; qt < 2; ++qt) {
                if (skip[qt]) continue;
                f32x16 S = zero16();
#pragma unroll
                for (int s = 0; s < 4; ++s) S = mfma32(Kf[s], Qf[qt][s], S);
                if (diag[qt]) {
#pragma unroll
                    for (int i = 0; i < 16; ++i) { const bool ok = (kb == 0) ? (crow(i, hh) >= r) : (crow(i, hh) <= r); S[i] = ok ? S[i] : -1e30f; }
                }
                float mx = S[0];
#pragma unroll
                for (int i = 1; i < 16; ++i) mx = fmaxf(mx, S[i]);
                mx = xmax32(mx);
                const float mnew = fmaxf(mrun[qt], mx), alpha = __builtin_amdgcn_exp2f(mrun[qt] - mnew);
                float ps = 0.f;
#pragma unroll
                for (int i = 0; i < 16; ++i) { S[i] = __builtin_amdgcn_exp2f(S[i] - mnew); ps += S[i]; }
                ps = xsum32(ps);
                lrun[qt] = lrun[qt] * alpha + ps; mrun[qt] = mnew;
#pragma unroll
                for (int i = 0; i < 16; ++i) { O[qt][0][i] *= alpha; O[qt][1][i] *= alpha; }
#pragma unroll
                for (int s = 0; s < 2; ++s) {
                    u32x4 pw; pw.x = pk2(S[8 * s], S[8 * s + 1]); pw.y = pk2(S[8 * s + 2], S[8 * s + 3]); pw.z = pk2(S[8 * s + 4], S[8 * s + 5]); pw.w = pk2(S[8 * s + 6], S[8 * s + 7]);
                    const bf16x8 pf = __builtin_bit_cast(bf16x8, pw);
                    O[qt][0] = mfma32(Vf[0][s], pf, O[qt][0]); O[qt][1] = mfma32(Vf[1][s], pf, O[qt][1]);
                }
            }
        }
        kb = kbn;
    }
#undef ATT_LOAD
#pragma unroll
    for (int qt = 0; qt < 2; ++qt) {
        const float invl = __builtin_amdgcn_rcpf(lrun[qt]); const int qi = qi0 + qt * 32 + r;
        bf16_t* op = aout + (size_t)(qbase + qi) * 512 + hq * 64;
#pragma unroll
        for (int dt = 0; dt < 2; ++dt)
#pragma unroll
            for (int g4 = 0; g4 < 4; ++g4) {
                u32x2 w; w.x = pk2(O[qt][dt][4 * g4] * invl, O[qt][dt][4 * g4 + 1] * invl); w.y = pk2(O[qt][dt][4 * g4 + 2] * invl, O[qt][dt][4 * g4 + 3] * invl);
                *(u32x2*)(op + dt * 32 + 8 * g4 + 4 * hh) = w; }
    }
    block_sync();
}

template <int DK, bool ML>
DI void scan_item(LAS uchar* lds, const Params& P, int layer, const bf16_t* z, int ch, int s, int mode, bf16_t* stbuf, float* dbuf, bf16_t* pb) {
    const bool full = mode != 0, loadst = mode == 1, wrst = mode != 1;
    constexpr int QSS = (DK + 8) * 2, TS = 144, NT = DK / 64, NE = ML ? 129 : 128;
    constexpr int O_QS = 0, O_KS = 17408, O_KST = 34816, O_VT = 53248, O_ST = 71680, O_BF = 106496, O_MISC = 122880;
    LAS uchar* QS = lds + O_QS; LAS uchar* KS = lds + O_KS; LAS uchar* KST = lds + O_KST; LAS uchar* VT = lds + O_VT; LAS uchar* ST = lds + O_ST;
    LAS float* BF = (LAS float*)(lds + O_BF);
    LAS float* bsc = (LAS float*)(lds + O_MISC); LAS float* gi = bsc + 64; LAS float* nvec = bsc + 128;
    LAS bf16_t* nb = (LAS bf16_t*)(lds + O_MISC + 1536);
    const int tid = otid(), wave = __builtin_amdgcn_readfirstlane(tid >> 6), lane = tid & 63, r = lane & 31, hh = lane >> 5;
    const int dir = ch & 1, h = (ch >> 1) & 3, lb = ch >> 3;
    int base_row, t0;
    if (s == 0) { base_row = HLAT + lb * CTXL; t0 = dir ? CTXL - 1 : 0; }
    else { const int sc = dir ? (32 - s) : (s - 1); base_row = lb * SEQ; t0 = sc * 256 + (dir ? 255 : 0); }
    const int tdir = dir ? -1 : 1;
    bf16_t* gst = stbuf + ((size_t)ch * NSC + s) * NE * DK;
    const int eb = wave & 3, dbase = (wave >> 2) * NT, ib = wave >> 2;
#define VT_OFF(e_, blk_) ((e_) * TS + ((((blk_) ^ ((e_) >> 4)) & 7) << 4))
#define KT_OFF(d_, blk_) ((d_) * TS + ((((blk_) ^ ((d_) >> 3)) & 7) << 4))
    f32x16 Sacc[NT]; float dsum[NT];
#pragma unroll
    for (int ti = 0; ti < NT; ++ti) { Sacc[ti] = zero16(); dsum[ti] = 0.f; }
    int ncur = 0;
    const float gate_fb = ML ? P.in[I_MFB][layer * 8 + dir * 4 + h] : 0.f, gate_ib = ML ? P.in[I_MIB][layer * 8 + dir * 4 + h] : 0.f;
    LAS float* W2S = (LAS float*)(lds + O_MISC + 2048);
    if constexpr (!ML) {
        const float* w2g = P.in[I_GW2] + (size_t)layer * 2 * 16 * 256 + dir * 16 * 256 + h * 64;
        for (int idx = tid; idx < 1024; idx += 512) W2S[idx] = w2g[(idx >> 6) * 256 + (idx & 63)];
        if (tid < 64) W2S[1024 + tid] = P.in[I_GB][(size_t)layer * 512 + dir * 256 + h * 64 + tid];
        block_sync();
    }
    const int j = tid >> 3, dseg = tid & 7;
    const bf16_t* cq = (const bf16_t*)(P.ws + WS_AOP) + PB_STRIDE;
    u32x4 rq0, rq1, rk0, rk1, rv0, rv1, rg0, rg1; float rmf = 0.f, rmi = 0.f;
    rq0 = rq1 = rk0 = rk1 = rv0 = rv1 = rg0 = rg1 = (u32x4){0u, 0u, 0u, 0u};
#define SCAN_LOAD(cc_) do { \
        const size_t row_ = (size_t)(base_row + t0 + tdir * ((cc_) * 64 + j)); \
        const bf16_t* zl_ = z + (size_t)(base_row + t0 + tdir * ((cc_) * 64 + lane)) * ZC; \
        if constexpr (!ML) { \
            const bf16_t* zp_ = z + row_ * ZC; \
            rg0 = *(const u32x4*)(zl_ + Z_GG + dir * 16); rg1 = *(const u32x4*)(zl_ + Z_GG + dir * 16 + 8); \
            if (full) rq0 = *(const u32x4*)(zp_ + Z_GQ + h * 64 + dseg * 8); rk0 = *(const u32x4*)(zp_ + Z_GK + h * 64 + dseg * 8); \
            rv0 = *(const u32x4*)(zp_ + Z_GV + h * 128 + dseg * 16); rv1 = *(const u32x4*)(zp_ + Z_GV + h * 128 + dseg * 16 + 8); \
        } else { \
            const bf16_t* qp_ = cq + row_ * 512 + h * 128 + dseg * 16; \
            if (full) { rq0 = *(const u32x4*)qp_; rq1 = *(const u32x4*)(qp_ + 8); } rk0 = *(const u32x4*)(qp_ + PB_STRIDE); rk1 = *(const u32x4*)(qp_ + PB_STRIDE + 8); \
            const bf16_t* vp_ = z + row_ * ZC + Z_MV + h * 128 + dseg * 16; rv0 = *(const u32x4*)vp_; rv1 = *(const u32x4*)(vp_ + 8); \
            if (wave == 0) { rmf = bf2f(zl_[Z_MF + dir * 4 + h]); rmi = bf2f(zl_[Z_MI + dir * 4 + h]); } \
        } } while (0)
    SCAN_LOAD(0);
    if (loadst) {
        for (int idx = tid; idx < 128 * DK / 8; idx += 512) { const int e = idx / (DK / 8), d8 = idx % (DK / 8); *(LAS u32x4*)(ST + e * QSS + d8 * 16) = *(const u32x4*)(gst + (size_t)e * DK + d8 * 8); }
        if (ML && tid < 128) { const bf16_t nraw = gst[(size_t)128 * DK + tid]; nvec[tid] = bf2f(nraw); nb[tid] = nraw; }
        block_sync();
#pragma unroll
        for (int ti = 0; ti < NT; ++ti)
#pragma unroll
            for (int i = 0; i < 16; ++i) Sacc[ti][i] = bf2f(*(const LAS bf16_t*)(ST + (eb * 32 + crow(i, hh)) * QSS + ((dbase + ti) * 32 + r) * 2));
    } else {
        if (ML && tid < 128) { nvec[tid] = 0.f; nb[tid] = 0; }
        if (full) { for (int idx = tid; idx < 128 * QSS / 16; idx += 512) *(LAS u32x4*)(ST + idx * 16) = (u32x4){0u, 0u, 0u, 0u}; }
    }
#pragma unroll 1
    for (int cc = 0; cc < 4; ++cc) {
        if constexpr (!ML) {
            float gf[16];
            { float t8[8]; unpack8(rg0, t8);
#pragma unroll
              for (int k = 0; k < 8; ++k) gf[k] = t8[k];
              unpack8(rg1, t8);
#pragma unroll
              for (int k = 0; k < 8; ++k) gf[8 + k] = t8[k]; }
            float la[8];
            { const f32x4 b0 = *(const LAS f32x4*)(W2S + 1024 + wave * 8), b1 = *(const LAS f32x4*)(W2S + 1024 + wave * 8 + 4);
#pragma unroll
              for (int k = 0; k < 4; ++k) { la[k] = b0[k]; la[4 + k] = b1[k]; } }
#pragma unroll
            for (int rr = 0; rr < 16; ++rr) {
                const f32x4 w0 = *(const LAS f32x4*)(W2S + rr * 64 + wave * 8), w1 = *(const LAS f32x4*)(W2S + rr * 64 + wave * 8 + 4);
#pragma unroll
                for (int k = 0; k < 4; ++k) { la[k] += w0[k] * gf[rr]; la[4 + k] += w1[k] * gf[rr]; }
            }
#pragma unroll
            for (int k = 0; k < 8; ++k) la[k] = logsigmoidf_(la[k]) * 0.0625f;
#pragma unroll
            for (int k = 0; k < 8; ++k) la[k] = wave_incl_scan(la[k]);
            *(LAS f32x4*)(BF + lane * 64 + wave * 8) = (f32x4){la[0], la[1], la[2], la[3]};
            *(LAS f32x4*)(BF + lane * 64 + wave * 8 + 4) = (f32x4){la[4], la[5], la[6], la[7]};
        } else {
            if (wave == 0) {
                const float mf = rmf + gate_fb;
                const float mi = rmi + gate_ib;
                float x = logsigmoidf_(mf);
                x = wave_incl_scan(x);
                bsc[lane] = x; gi[lane] = mi;
            }
        }
        if (full && cc > 0) {
#pragma unroll
            for (int ti = 0; ti < NT; ++ti)
#pragma unroll
                for (int i = 0; i < 16; ++i) *(LAS bf16_t*)(ST + (eb * 32 + crow(i, hh)) * QSS + ((dbase + ti) * 32 + r) * 2) = f2bf(Sacc[ti][i]);
        }
        block_sync();
        if constexpr (!ML) {
            float bj[8], qf[8], kf[8];
#pragma unroll
            for (int k = 0; k < 8; ++k) bj[k] = BF[j * 64 + dseg * 8 + k];
            unpack8(rk0, kf);
#pragma unroll
            for (int k = 0; k < 8; ++k) kf[k] *= __expf(-bj[k]);
            const u32x4 kw = pack8(kf);
            if (full) {
                unpack8(rq0, qf);
#pragma unroll
                for (int k = 0; k < 8; ++k) qf[k] *= 0.125f * __expf(bj[k]);
                *(LAS u32x4*)(QS + j * QSS + dseg * 16) = pack8(qf);
                *(LAS u32x4*)(KS + j * QSS + dseg * 16) = kw;
            }
            const unsigned kwv[4] = {kw.x, kw.y, kw.z, kw.w};
#pragma unroll
            for (int k = 0; k < 4; ++k) {
                *(LAS bf16_t*)(KST + KT_OFF(dseg * 8 + 2 * k, j >> 3) + (j & 7) * 2) = (bf16_t)(kwv[k] & 0xffffu);
                *(LAS bf16_t*)(KST + KT_OFF(dseg * 8 + 2 * k + 1, j >> 3) + (j & 7) * 2) = (bf16_t)(kwv[k] >> 16); }
        } else {
            const float bjv = bsc[j], eq = __expf(bjv), ek = __expf(gi[j] - bjv);
#pragma unroll
            for (int part = 0; part < 2; ++part) {
                const int c8 = dseg * 16 + part * 8; float qf[8], kf[8];
                unpack8(part ? rk1 : rk0, kf);
#pragma unroll
                for (int k = 0; k < 8; ++k) kf[k] *= ek;
                const u32x4 w = pack8(kf);
                if (full) {
                    unpack8(part ? rq1 : rq0, qf);
#pragma unroll
                    for (int k = 0; k < 8; ++k) qf[k] *= eq;
                    *(LAS u32x4*)(QS + j * QSS + c8 * 2) = pack8(qf);
                    *(LAS u32x4*)(KS + j * QSS + c8 * 2) = w;
                }
                const unsigned wv[4] = {w.x, w.y, w.z, w.w};
#pragma unroll
                for (int k = 0; k < 4; ++k) {
                    *(LAS bf16_t*)(KST + KT_OFF(c8 + 2 * k, j >> 3) + (j & 7) * 2) = (bf16_t)(wv[k] & 0xffffu);
                    *(LAS bf16_t*)(KST + KT_OFF(c8 + 2 * k + 1, j >> 3) + (j & 7) * 2) = (bf16_t)(wv[k] >> 16); }
            }
        }
        {
            const unsigned vw[8] = {rv0.x, rv0.y, rv0.z, rv0.w, rv1.x, rv1.y, rv1.z, rv1.w};
#pragma unroll
            for (int k = 0; k < 8; ++k) {
                *(LAS bf16_t*)(VT + VT_OFF(dseg * 16 + 2 * k, j >> 3) + (j & 7) * 2) = (bf16_t)(vw[k] & 0xffffu);
                *(LAS bf16_t*)(VT + VT_OFF(dseg * 16 + 2 * k + 1, j >> 3) + (j & 7) * 2) = (bf16_t)(vw[k] >> 16); }
        }
        if (cc < 3) SCAN_LOAD(cc + 1);
        block_sync();
        if (full) {
            f32x16 o = zero16(), o2 = zero16(), dn = zero16();
            const int erow = eb * 32 + r;
#pragma unroll
            for (int jb = 0; jb < 2; ++jb) {
                if (jb <= ib) {
                    f32x16 x = zero16();
#pragma unroll 4
                    for (int k = 0; k < DK / 16; ++k) x = mfma32(lds_frag(KS + (jb * 32 + r) * QSS + (16 * k + 8 * hh) * 2), lds_frag(QS + (ib * 32 + r) * QSS + (16 * k + 8 * hh) * 2), x);
                    if (jb == ib) {
#pragma unroll
                        for (int i = 0; i < 16; ++i) x[i] = (crow(i, hh) <= r) ? x[i] : 0.f; }
#pragma unroll
                    for (int sx = 0; sx < 2; ++sx) {
                        u32x4 pw; pw.x = pk2(x[8 * sx], x[8 * sx + 1]); pw.y = pk2(x[8 * sx + 2], x[8 * sx + 3]); pw.z = pk2(x[8 * sx + 4], x[8 * sx + 5]); pw.w = pk2(x[8 * sx + 6], x[8 * sx + 7]);
                        const u32x2 lo = *(const LAS u32x2*)(VT + VT_OFF(erow, jb * 4 + 2 * sx) + 8 * hh), hi = *(const LAS u32x2*)(VT + VT_OFF(erow, jb * 4 + 2 * sx + 1) + 8 * hh);
                        u32x4 vb; vb.x = lo.x; vb.y = lo.y; vb.z = hi.x; vb.w = hi.y;
                        o = mfma32(__builtin_bit_cast(bf16x8, pw), __builtin_bit_cast(bf16x8, vb), o);
                        if (ML) dn = mfma32(__builtin_bit_cast(bf16x8, pw), __builtin_bit_cast(bf16x8, (u32x4){0x3F803F80u, 0x3F803F80u, 0x3F803F80u, 0x3F803F80u}), dn);
                    }
                }
            }
#pragma unroll 4
            for (int k = 0; k < DK / 16; ++k) {
                const bf16x8 qf = lds_frag(QS + (ib * 32 + r) * QSS + (16 * k + 8 * hh) * 2);
                o2 = mfma32(qf, lds_frag(ST + erow * QSS + (16 * k + 8 * hh) * 2), o2);
                if (ML) dn = mfma32(qf, *(const LAS bf16x8*)(nb + ncur * 128 + 16 * k + 8 * hh), dn);
            }
#pragma unroll
            for (int i = 0; i < 16; ++i) {
                const int itok = ib * 32 + crow(i, hh); float val = o[i] + o2[i];
                if (ML) val = val * __builtin_amdgcn_rcpf(fmaxf(fabsf(dn[i]), 1.f));
                const size_t row = (size_t)(base_row + t0 + tdir * (cc * 64 + itok));
                pb[((size_t)dir * HROWS + row) * 512 + h * 128 + eb * 32 + r] = f2bf(val);
            }
        }
        {
            const int erow = eb * 32 + r;
#pragma unroll
            for (int ti = 0; ti < NT; ++ti) {
                const int drow = (dbase + ti) * 32 + r;
#pragma unroll
                for (int k = 0; k < 4; ++k) Sacc[ti] = mfma32(lds_frag(VT + VT_OFF(erow, 2 * k + hh)), lds_frag(KST + KT_OFF(drow, 2 * k + hh)), Sacc[ti]);
                const float bl = ML ? bsc[63] : BF[63 * 64 + drow]; const float dec = __expf(bl);
#pragma unroll
                for (int i = 0; i < 16; ++i) Sacc[ti][i] *= dec;
                dsum[ti] += bl;
            }
            if (ML && tid < 128) {
                float nn = nvec[ncur * 128 + tid];
#pragma unroll
                for (int q = 0; q < 8; ++q) { float kf[8]; unpack8(*(const LAS u32x4*)(KST + tid * TS + q * 16), kf);
#pragma unroll
                    for (int k = 0; k < 8; ++k) nn += kf[k]; }
                const float nnew = nn * __expf(bsc[63]); nvec[(ncur ^ 1) * 128 + tid] = nnew; nb[(ncur ^ 1) * 128 + tid] = f2bf(nnew);
            }
        }
        ncur ^= 1;
        block_sync();
    }
    if (wrst) {
#pragma unroll
        for (int ti = 0; ti < NT; ++ti) {
            const int db = dbase + ti;
#pragma unroll
            for (int i = 0; i < 16; ++i) gst[(size_t)(eb * 32 + crow(i, hh)) * DK + db * 32 + r] = f2bf(Sacc[ti][i]);
            if (eb == 0 && hh == 0) dbuf[((size_t)ch * NSC + s) * DK + db * 32 + r] = __expf(dsum[ti]);
        }
        if (ML && tid < 128) gst[(size_t)128 * DK + tid] = f2bf(nvec[ncur * 128 + tid]);
    }
    block_sync();
#undef SCAN_LOAD
#undef VT_OFF
#undef KT_OFF
}

DI void phase_conv_qk(const Params& P, int layer) {
    const bf16_t* z = (const bf16_t*)(P.ws + WS_BIG); bf16_t* cq = (bf16_t*)(P.ws + WS_AOP) + PB_STRIDE;
    const float* cw = P.in[I_CONVW] + (size_t)layer * 5 * 1024; const float* cbp = P.in[I_CONVB] + (size_t)layer * 1024;
    const int gt = blockIdx.x * 512 + otid(), cch = (gt & 127) * 8, rstride = gridDim.x * 4;
    float wt[5][8], bias[8];
    { const f32x4 b0 = *(const f32x4*)(cbp + cch), b1 = *(const f32x4*)(cbp + cch + 4);
#pragma unroll
      for (int k = 0; k < 4; ++k) { bias[k] = b0[k]; bias[4 + k] = b1[k]; } }
#pragma unroll
    for (int tau = 0; tau < 5; ++tau) { const f32x4 w0 = *(const f32x4*)(cw + tau * 1024 + cch), w1 = *(const f32x4*)(cw + tau * 1024 + cch + 4);
#pragma unroll
        for (int k = 0; k < 4; ++k) { wt[tau][k] = w0[k]; wt[tau][4 + k] = w1[k]; } }
    const float sc = cch >= 512 ? 0.08838834764831845f : 1.f;
    bf16_t* outp = cq + (size_t)(cch >= 512 ? 1 : 0) * PB_STRIDE + (cch & 511);
    u32x4 xn[5];
#define CONV_LOAD(lr_) do { const int t_ = (lr_) < HLAT ? ((lr_) & (SEQ - 1)) : (((lr_) - HLAT) & (CTXL - 1)); const int sl_ = (lr_) < HLAT ? SEQ : CTXL; \
        _Pragma("unroll") for (int tau = 0; tau < 5; ++tau) { const int tt_ = t_ + tau - 2; const int rr_ = (tt_ >= 0 && tt_ < sl_) ? (lr_) + tau - 2 : (lr_); \
            xn[tau] = *(const u32x4*)(z + (size_t)rr_ * ZC + Z_MQ + cch); } } while (0)
    int lr = gt >> 7;
    if (lr < HROWS) CONV_LOAD(lr);
    for (; lr < HROWS; lr += rstride) {
        u32x4 xc[5];
#pragma unroll
        for (int tau = 0; tau < 5; ++tau) xc[tau] = xn[tau];
        if (lr + rstride < HROWS) CONV_LOAD(lr + rstride);
        const int t = lr < HLAT ? (lr & (SEQ - 1)) : ((lr - HLAT) & (CTXL - 1)), seqlen = lr < HLAT ? SEQ : CTXL;
        float a[8];
#pragma unroll
        for (int k = 0; k < 8; ++k) a[k] = bias[k];
#pragma unroll
        for (int tau = 0; tau < 5; ++tau) {
            const int tt = t + tau - 2; const float vs = (tt >= 0 && tt < seqlen) ? 1.f : 0.f;
            float xf[8]; unpack8(xc[tau], xf);
#pragma unroll
            for (int k = 0; k < 8; ++k) a[k] += wt[tau][k] * (xf[k] * vs);
        }
#pragma unroll
        for (int k = 0; k < 8; ++k) a[k] = siluf_(a[k]) * sc;
        *(u32x4*)(outp + (size_t)lr * 512) = pack8(a);
    }
#undef CONV_LOAD
}

DI void phase_scan_carry(const Params& P) {
    constexpr int NG = 16 * 128 * 16, NM = 16 * 129 * 32;
    for (int idx = blockIdx.x * 512 + otid(); idx < NG + NM; idx += gridDim.x * 512) {
        bf16_t* st; const float* dp; size_t sstride; int dstride;
        if (idx < NG) { const int ch = idx >> 11, rem = idx & 2047, e = rem >> 4, d4 = rem & 15;
            st = (bf16_t*)(P.ws + WS_STG) + (size_t)ch * NSC * 128 * 64 + e * 64 + d4 * 4; sstride = 128 * 64; dp = (const float*)(P.ws + WS_DG) + (size_t)ch * NSC * 64 + d4 * 4; dstride = 64; }
        else { const int i2 = idx - NG, ch = i2 / (129 * 32), rem = i2 % (129 * 32), e = rem >> 5, d4 = rem & 31;
            st = (bf16_t*)(P.ws + WS_STM) + (size_t)ch * NSC * 129 * 128 + e * 128 + d4 * 4; sstride = 129 * 128; dp = (const float*)(P.ws + WS_DM) + (size_t)ch * NSC * 128 + d4 * 4; dstride = 128; }
        f32x4 carry = {0.f, 0.f, 0.f, 0.f};
#pragma unroll 1
        for (int s0 = 0; s0 < NSC - 1; s0 += 8) {
            u32x2 L[8]; f32x4 dc[8];
#pragma unroll
            for (int k = 0; k < 8; ++k) { L[k] = *(const u32x2*)(st + (size_t)(s0 + k) * sstride); dc[k] = *(const f32x4*)(dp + (s0 + k) * dstride); }
#pragma unroll
            for (int k = 0; k < 8; ++k) {
                u32x2 w; w.x = pk2(carry[0], carry[1]); w.y = pk2(carry[2], carry[3]);
                *(u32x2*)(st + (size_t)(s0 + k) * sstride) = w;
                const f32x4 l = {bflo(L[k].x), bfhi(L[k].x), bflo(L[k].y), bfhi(L[k].y)};
                carry = dc[k] * carry + l;
            }
        }
        { u32x2 w; w.x = pk2(carry[0], carry[1]); w.y = pk2(carry[2], carry[3]); *(u32x2*)(st + (size_t)(NSC - 1) * sstride) = w; }
    }
}

DI void phase_merge_prep(const Params& P, int layer, int nrows) {
    const int tid = otid(), lane = tid & 63, wave = tid >> 6, c = lane * 8;
    const bf16_t* z = (const bf16_t*)(P.ws + WS_BIG); const bf16_t* pb = (const bf16_t*)(P.ws + WS_PB); bf16_t* aop = (bf16_t*)(P.ws + WS_AOP);
    const int stride = gridDim.x * 8;
    int lr = blockIdx.x * 8 + wave;
    u32x4 na[2], nbv[2], ng[2];
#define PREP_LOAD(row_) do { _Pragma("unroll") for (int mx = 0; mx < 2; ++mx) { \
        na[mx] = *(const u32x4*)(pb + (size_t)(2 * mx) * PB_STRIDE + (size_t)(row_) * 512 + c); nbv[mx] = *(const u32x4*)(pb + (size_t)(2 * mx + 1) * PB_STRIDE + (size_t)(row_) * 512 + c); \
        ng[mx] = *(const u32x4*)(z + (size_t)(row_) * ZC + (mx ? Z_MO : Z_GR) + c); } } while (0)
    float gnr[2][8];
#pragma unroll
    for (int mx = 0; mx < 2; ++mx) { const float* gn = (mx ? P.in[I_MNORM] : P.in[I_GNORM]) + layer * 128 + (c & 127);
#pragma unroll
        for (int k = 0; k < 8; ++k) gnr[mx][k] = gn[k]; }
    if (lr < nrows) PREP_LOAD(lr);
    for (; lr < nrows; lr += stride) {
        u32x4 ca[2], cb[2], cg[2];
#pragma unroll
        for (int mx = 0; mx < 2; ++mx) { ca[mx] = na[mx]; cb[mx] = nbv[mx]; cg[mx] = ng[mx]; }
        if (lr + stride < nrows) PREP_LOAD(lr + stride);
#pragma unroll
        for (int mx = 0; mx < 2; ++mx) {
            float a[8], b[8], gt[8];
            unpack8(ca[mx], a); unpack8(cb[mx], b); unpack8(cg[mx], gt);
            float ss = 0.f;
#pragma unroll
            for (int k = 0; k < 8; ++k) { a[k] += b[k]; ss += a[k] * a[k]; }
            ss = row16_sum(ss);
            const float rstd = rsqrtf(ss * (1.f / 128.f) + 1e-6f);
#pragma unroll
            for (int k = 0; k < 8; ++k) a[k] = a[k] * rstd * gnr[mx][k] * (mx ? sigmoidf_(gt[k]) : siluf_(gt[k]));
            *(u32x4*)(aop + (size_t)(1 + mx) * PB_STRIDE + (size_t)lr * 512 + c) = pack8(a);
        }
    }
#undef PREP_LOAD
}


#include <vector>


#define XB_TMO      128
#define XB_XCNT(j)  (256  + 64 * (j))
#define XB_XSUB(j)  (1280 + 64 * (j))
#define XB_XGEN(j)  (2304 + 64 * (j))
#define XB_TOP      3328
#define XB_TOPGEN   3392
#define XCD_BAR_WORDS 3456
#define XB_SPIN_CAP (1u << 18)

__device__ __forceinline__ unsigned xb_ld(unsigned* p)              { return __hip_atomic_load(p, __ATOMIC_RELAXED, __HIP_MEMORY_SCOPE_AGENT); }
__device__ __forceinline__ unsigned xb_add(unsigned* p, unsigned v) { return __hip_atomic_fetch_add(p, v, __ATOMIC_RELAXED, __HIP_MEMORY_SCOPE_AGENT); }
__device__ __forceinline__ unsigned xb_xcc_id() { return (unsigned)__builtin_amdgcn_s_getreg((3 << 11) | 20) & 0xFu; }
#define XB_SPIN(cond, bar) do { unsigned _sp = 0; while (cond) { __builtin_amdgcn_s_sleep(1); \
    if ((++_sp & 255u) == 0u) { if (xb_ld(&(bar)[XB_TMO])) break; if (_sp > XB_SPIN_CAP) { atomicAdd(&(bar)[XB_TMO], 1u); break; } } } } while (0)

struct XcdBarrier {
    unsigned* bar; unsigned x;
    volatile LAS unsigned* st;
};

__device__ __forceinline__ XcdBarrier xcd_barrier_post(unsigned* bar, volatile LAS unsigned* st) {
    XcdBarrier b; b.bar = bar; b.x = xb_xcc_id(); b.st = st;
    if (threadIdx.x == 0) (void)xb_add(&bar[XB_XCNT(b.x)], 1u);
    return b;
}
__device__ __forceinline__ void xcd_barrier_complete(unsigned* bar, unsigned x, unsigned& nloc, unsigned& nx) {
    const unsigned G = gridDim.x * gridDim.y * gridDim.z;
    unsigned sum, cnt, mine, sp = 0u;
    for (;;) {
        sum = 0u; cnt = 0u; mine = 0u;
#pragma unroll
        for (unsigned j = 0; j < 16; ++j) { const unsigned c = xb_ld(&bar[XB_XCNT(j)]); sum += c; cnt += (c > 0u) ? 1u : 0u; mine = (j == x) ? c : mine; }
        if (sum == G) break;
        __builtin_amdgcn_s_sleep(1);
        if ((++sp & 255u) == 0u) { if (xb_ld(&bar[XB_TMO])) break; if (sp > XB_SPIN_CAP) { atomicAdd(&bar[XB_TMO], 1u); break; } }
    }
    nloc = mine > 0u ? mine : 1u; nx = cnt > 0u ? cnt : 1u;
}

__device__ __forceinline__ void xcd_barrier(const XcdBarrier& b) {
    asm volatile("s_waitcnt vmcnt(0)" ::: "memory");
    __syncthreads();
    if (threadIdx.x == 0) {
        unsigned* bar = b.bar;
        __builtin_amdgcn_s_waitcnt(0);
        unsigned nloc = b.st[0], nx = b.st[1];
        if (nloc == 0u) { xcd_barrier_complete(bar, b.x, nloc, nx); b.st[0] = nloc; b.st[1] = nx; }
        const unsigned old = xb_add(&bar[XB_XSUB(b.x)], 1u);
        const unsigned gen = old / nloc;
        if (old + 1u == (gen + 1u) * nloc) {
            __builtin_amdgcn_fence(__ATOMIC_RELEASE, "agent");
            asm volatile("s_waitcnt vmcnt(0)" ::: "memory");
            const unsigned og = xb_add(&bar[XB_TOP], 1u);
            const unsigned tg = og / nx;
            if (og + 1u == (tg + 1u) * nx) xb_add(&bar[XB_TOPGEN], 1u);
            else XB_SPIN(xb_ld(&bar[XB_TOPGEN]) == tg, bar);
            __builtin_amdgcn_fence(__ATOMIC_ACQUIRE, "agent");
            xb_add(&bar[XB_XGEN(b.x)], 1u);
            asm volatile("s_waitcnt vmcnt(0)" ::: "memory");
        } else {
            XB_SPIN(xb_ld(&bar[XB_XGEN(b.x)]) == gen, bar);
            __builtin_amdgcn_fence(__ATOMIC_ACQUIRE, "agent");
            asm volatile("s_waitcnt vmcnt(0)" ::: "memory");
        }
    }
    __syncthreads();
}

DI int next_item(unsigned* ctr, LAS uchar* lds) {
    volatile LAS unsigned* w = (volatile LAS unsigned*)(lds + LDS_BYTES - 8);
    __syncthreads();
    if (threadIdx.x == 0) *w = atomicAdd(ctr, 1u);
    __syncthreads();
    return (int)*w;
}
#ifdef PROBE_TS
#define SYNC(cls) do { grid.sync(); if (blockIdx.x == 0 && threadIdx.x == 0) { const unsigned long long t_ = __builtin_amdgcn_s_memrealtime(); ((unsigned long long*)P.ws)[16 + (cls)] += t_ - ((unsigned long long*)P.ws)[0]; ((unsigned long long*)P.ws)[0] = t_; } } while (0)
#else
#ifdef PROBE_SYNC2
#define SYNC(cls) do { grid.sync(); grid.sync(); } while (0)
#else
#define SYNC(cls) xcd_barrier(xb)
#endif
#endif
#ifdef PROBE_MIX2
#define MIXREP 2
#else
#define MIXREP 1
#endif
__global__ void __launch_bounds__(512, 2) hybrid_fwd(Params P) {
    extern __shared__ __attribute__((aligned(16))) uchar shm[];
    LAS uchar* lds = (LAS uchar*)shm;
    cg::grid_group grid = cg::this_grid();
    { volatile LAS unsigned* st = (volatile LAS unsigned*)(lds + LDS_BYTES - 16); if (threadIdx.x == 0) { st[0] = 0u; st[1] = 0u; st[2] = 0u; st[3] = 0u; } }
    __syncthreads();
    XcdBarrier xb = xcd_barrier_post((unsigned*)P.ws, (volatile LAS unsigned*)(lds + LDS_BYTES - 16));
    uchar* ws = P.ws;
    bf16_t* WT = (bf16_t*)(ws + WS_WT); bf16_t* XN = (bf16_t*)(ws + WS_XN); bf16_t* BIG = (bf16_t*)(ws + WS_BIG); bf16_t* AOP = (bf16_t*)(ws + WS_AOP); bf16_t* PB = (bf16_t*)(ws + WS_PB);
    float* XC = (float*)(ws + WS_XC); const float* MOD = (const float*)(ws + WS_MOD);
#ifdef PROBE_TS
    if (blockIdx.x == 0 && threadIdx.x == 0) { for (int i = 0; i < 32; ++i) ((unsigned long long*)P.ws)[16 + i] = 0ull; ((unsigned long long*)P.ws)[0] = __builtin_amdgcn_s_memrealtime(); }
#endif
#ifdef PROBE_MODS
    phase_mods(lds, P);
#endif
    phase_mods(lds, P); phase_rope(P);
    for (int layer = 0; layer < 2; ++layer) {
        const bool last = layer == 1;
        const float* xl = layer == 0 ? P.in[I_X] : P.out; const float* xc = layer == 0 ? P.in[I_CTX] : XC;
        const float* modl = MOD + (size_t)layer * 5 * NMOD * D;
        const CtxRed nored{nullptr, 0, 1, XC}, w2red{(const float*)PB, DFF / 256, NCTX, XC}, wored{(const float*)(ws + WS_WOPART), D / 256, HCTX, XC};
#ifdef PROBE_CONV
        phase_convert(lds, P, layer);
#endif
        phase_convert(lds, P, layer);
        if (P.ws == nullptr) grid.sync();
        if (layer == 0) SYNC(0);
#ifdef PROBE_ADALN
        phase_adaln(P, layer, 0, xl, xc, XN, NTOK, -1, layer ? w2red : nored, 0, 0);
#endif
        phase_adaln(P, layer, 0, xl, xc, XN, NTOK, -1, layer ? w2red : nored, 0, 0);
        SYNC(1);
#ifdef PROBE_G13
        { Sched S; S.init(NTOK / BM, 2 * DFF / BM, D, XN, WT + WT_W13A); EpiSwiGLU E{BIG}; gemm_phase(lds, S, E); }
#endif
        { Sched S; S.init(NTOK / BM, 2 * DFF / BM, D, XN, WT + WT_W13A); EpiSwiGLU E{BIG}; gemm_phase(lds, S, E); }
        SYNC(2);
#ifdef PROBE_G2
        { Sched S; S.init(NTOK / BM, D / BM, DFF, BIG, WT + WT_W2A); EpiResid E{xl, xc, P.out, XC, modl, 2, 0.25f, -1}; gemm_phase(lds, S, E); }
        { Sched S; S.init(NTOK / BM, D / BM, DFF, BIG, WT + WT_W2A); EpiResid E{P.out, XC, P.out, XC, modl, 2, 0.25f, -1}; gemm_phase(lds, S, E); }
#else
        { Sched S; S.init(NLAT / BM, D / BM, DFF, BIG, WT + WT_W2A); EpiResid E{xl, xc, P.out, XC, modl, 2, 0.5f, -1}; gemm_phase(lds, S, E); }
        { Sched S; S.init_tail(NLAT / BM, NCTX / BM, D / BM, 256, DFF / 256, DFF, BIG, WT + WT_W2A); EpiPartial E{(float*)PB, modl, 2, 0.5f, NLAT / BM, 0, DFF / 256, NCTX}; gemm_phase(lds, S, E); }
#endif
        SYNC(3);
        const int nMh = last ? HLAT / BM : HROWS / BM;
        for (int hf = 0; hf < 2; ++hf) {
#ifdef PROBE_ADALN
            phase_adaln(P, layer, 1, P.out, hf == 0 ? xc : (const float*)XC, XN, HROWS, hf, hf == 0 ? w2red : nored, HCTX, hf == 0 ? NCTX : 0);
#endif
            phase_adaln(P, layer, 1, P.out, hf == 0 ? xc : (const float*)XC, XN, HROWS, hf, hf == 0 ? w2red : nored, HCTX, hf == 0 ? NCTX : 0);
            SYNC(1);
#ifdef PROBE_GIN
            { Sched S; S.init(HROWS / BM, ZC / BM, D, XN, WT + WT_WIN); EpiZ E{BIG}; gemm_phase(lds, S, E); }
#endif
            { Sched S; S.init(HROWS / BM, ZC / BM, D, XN, WT + WT_WIN); EpiZ E{BIG}; gemm_phase(lds, S, E); }
            SYNC(4);
            {
                unsigned* ctra = (unsigned*)(ws + WS_CTR) + ((layer * 2 + hf) * 2 + 0) * 64 + 32;
                phase_conv_qk(P, layer);
                for (int i2 = next_item(ctra, lds); i2 < 256; i2 = next_item(ctra, lds)) attn_item(lds, P, layer, BIG, AOP, i2);
            }
            SYNC(4);
            {
                unsigned* ctr = (unsigned*)(ws + WS_CTR) + ((layer * 2 + hf) * 2 + 0) * 64;
                const int natt = last ? 0 : 8, mode0 = last ? 0 : 2;
                for (int i2 = next_item(ctr, lds); i2 < 1024 + natt; i2 = next_item(ctr, lds)) {
                    if (i2 < natt) attn_item(lds, P, layer, BIG, AOP, 256 + i2);
                    else if (i2 < natt + 512) { const int i3 = i2 - natt; scan_item<128, true>(lds, P, layer, BIG, i3 >> 5, i3 & 31, (i3 & 31) ? 0 : mode0, (bf16_t*)(ws + WS_STM), (float*)(ws + WS_DM), PB + 2 * PB_STRIDE); }
                    else { const int i3 = i2 - natt - 512; scan_item<64, false>(lds, P, layer, BIG, i3 >> 5, i3 & 31, (i3 & 31) ? 0 : mode0, (bf16_t*)(ws + WS_STG), (float*)(ws + WS_DG), PB); }
                }
            }
            SYNC(5);
            phase_scan_carry(P);
            SYNC(6);
            {
                unsigned* ctr = (unsigned*)(ws + WS_CTR) + ((layer * 2 + hf) * 2 + 1) * 64;
                for (int i2 = next_item(ctr, lds); i2 < 1024; i2 = next_item(ctr, lds)) {
                    if (i2 < 512) scan_item<128, true>(lds, P, layer, BIG, i2 >> 5, 1 + (i2 & 31), 1, (bf16_t*)(ws + WS_STM), nullptr, PB + 2 * PB_STRIDE);
                    else scan_item<64, false>(lds, P, layer, BIG, (i2 - 512) >> 5, 1 + (i2 & 31), 1, (bf16_t*)(ws + WS_STG), nullptr, PB);
                }
            }
            SYNC(7);
#ifdef PROBE_PREP
            phase_merge_prep(P, layer, last ? HLAT : HROWS);
#endif
            phase_merge_prep(P, layer, last ? HLAT : HROWS);
            SYNC(8);
#ifdef PROBE_GMERGE
            { Sched S; S.init(nMh, D / BM, 512, AOP, WT + WT_WOUT, 3, PB_STRIDE * 2, (size_t)D * 512 * 2); EpiMerge E{XN, BIG}; gemm_phase(lds, S, E); }
#endif
            { Sched S; S.init(nMh, D / BM, 512, AOP, WT + WT_WOUT, 3, PB_STRIDE * 2, (size_t)D * 512 * 2); EpiMerge E{XN, BIG}; gemm_phase(lds, S, E); }
            SYNC(9);
#ifdef PROBE_GWO
            { Sched S; S.init(nMh, D / BM, D, XN, WT + WT_WO); EpiResid E{P.out, XC, P.out, XC, modl, 5, 0.5f, hf}; gemm_phase(lds, S, E); }
            { Sched S; S.init(nMh, D / BM, D, XN, WT + WT_WO); EpiResid E{P.out, XC, P.out, XC, modl, 5, 0.5f, hf}; gemm_phase(lds, S, E); }
#else
            { Sched S; S.init(HLAT / BM, D / BM, D, XN, WT + WT_WO); EpiResid E{P.out, XC, P.out, XC, modl, 5, 1.0f, hf}; gemm_phase(lds, S, E); }
            if (!last) { Sched S; S.init_tail(HLAT / BM, HCTX / BM, D / BM, 256, D / 256, D, XN, WT + WT_WO); EpiPartial E{(float*)(ws + WS_WOPART), modl, 5, 1.0f, HLAT / BM, hf, D / 256, HCTX}; gemm_phase(lds, S, E); }
#endif
            SYNC(10);
        }
        const int nrows2 = last ? NLAT : NTOK;
#ifdef PROBE_ADALN
        phase_adaln(P, layer, 2, P.out, XC, XN, nrows2, -1, last ? nored : wored, 0, 0);
#endif
        phase_adaln(P, layer, 2, P.out, XC, XN, nrows2, -1, last ? nored : wored, 0, 0);
        SYNC(1);
#ifdef PROBE_G13
        { Sched S; S.init(nrows2 / BM, 2 * DFF / BM, D, XN, WT + WT_W13B); EpiSwiGLU E{BIG}; gemm_phase(lds, S, E); }
#endif
        { Sched S; S.init(nrows2 / BM, 2 * DFF / BM, D, XN, WT + WT_W13B); EpiSwiGLU E{BIG}; gemm_phase(lds, S, E); }
        SYNC(2);
#ifdef PROBE_G2
        { Sched S; S.init(nrows2 / BM, D / BM, DFF, BIG, WT + WT_W2B); EpiResid E{P.out, XC, P.out, XC, modl, 8, 0.25f, -1}; gemm_phase(lds, S, E); }
        { Sched S; S.init(nrows2 / BM, D / BM, DFF, BIG, WT + WT_W2B); EpiResid E{P.out, XC, P.out, XC, modl, 8, 0.25f, -1}; gemm_phase(lds, S, E); }
#else
        { Sched S; S.init(NLAT / BM, D / BM, DFF, BIG, WT + WT_W2B); EpiResid E{P.out, XC, P.out, XC, modl, 8, 0.5f, -1}; gemm_phase(lds, S, E); }
        if (!last) { Sched S; S.init_tail(NLAT / BM, NCTX / BM, D / BM, 256, DFF / 256, DFF, BIG, WT + WT_W2B); EpiPartial E{(float*)PB, modl, 8, 0.5f, NLAT / BM, 0, DFF / 256, NCTX}; gemm_phase(lds, S, E); }
#endif
        SYNC(3);
    }
#ifdef PROBE_TS
    SYNC(11); SYNC(12);
    if (blockIdx.x == 0) {
        const unsigned long long* ts = (const unsigned long long*)P.ws + 16;
        const float ta = (float)ts[PROBE_A] * 0.01f, tb = (float)ts[PROBE_B] * 0.01f;
        if (threadIdx.x == 0) P.out[0] += ta;
        for (int i = 1 + threadIdx.x; i < 1 + (1 << 22); i += 512) P.out[i] += tb * 0.01f;
    }
#endif
}

extern "C" void kernel_launch(void* const* d_in, const int* in_sizes, int n_in, void* d_out, int out_size, void* d_ws, size_t ws_size, hipStream_t stream) {
    static int grid_blocks = 0;
    if (!grid_blocks) {
        int dev = 0, cus = 0, per_cu = 0;
        hipGetDevice(&dev);
        hipDeviceGetAttribute(&cus, hipDeviceAttributeMultiprocessorCount, dev);
        hipFuncSetAttribute((const void*)hybrid_fwd, hipFuncAttributeMaxDynamicSharedMemorySize, LDS_BYTES);
        hipOccupancyMaxActiveBlocksPerMultiprocessor(&per_cu, (const void*)hybrid_fwd, 512, LDS_BYTES);
        if (per_cu < 1) per_cu = 1;
        grid_blocks = cus * (per_cu > 1 ? 1 : per_cu);
        if (ws_size < WS_END) fprintf(stderr, "kernel_launch: workspace too small: %zu < %zu\n", ws_size, (size_t)WS_END);
    }
    Params p{};
    for (int i = 0; i < 27; ++i) p.in[i] = (const float*)d_in[i];
    p.out = (float*)d_out; p.ws = (uchar*)d_ws;
    (void)hipMemsetAsync(d_ws, 0, WS_CTL_BYTES, stream);
    void* args[] = {&p};
    hipError_t e = hipLaunchCooperativeKernel((const void*)hybrid_fwd, dim3(grid_blocks), dim3(512), args, LDS_BYTES, stream);
    if (e != hipSuccess) fprintf(stderr, "cooperative launch failed: %s (grid %d)\n", hipGetErrorString(e), grid_blocks);
}
```

```cpp
#include <hip/hip_runtime.h>
#include <hip/hip_cooperative_groups.h>
#include <cstdio>
namespace cg = cooperative_groups;

#define DI __device__ __forceinline__
#define LAS __attribute__((address_space(3)))
typedef unsigned short bf16_t;
typedef unsigned char uchar;
typedef short bf16x8 __attribute__((ext_vector_type(8)));
typedef float f32x4 __attribute__((ext_vector_type(4)));
typedef float f32x2 __attribute__((ext_vector_type(2)));
typedef float f32x16 __attribute__((ext_vector_type(16)));
typedef unsigned u32x4 __attribute__((ext_vector_type(4)));
typedef unsigned u32x2 __attribute__((ext_vector_type(2)));
typedef __bf16 hbf2 __attribute__((ext_vector_type(2)));

constexpr int D = 1024, NBATCH = 4, SEQ = 8192, CTXL = 256, DFF = 2816, NMOD = 9;
constexpr int NLAT = NBATCH * SEQ, NCTX = NBATCH * CTXL, NTOK = NLAT + NCTX;
constexpr int HLAT = 2 * SEQ, HCTX = 2 * CTXL, HROWS = HLAT + HCTX;
constexpr int ZC = 7680;
constexpr int Z_AQ = 0, Z_AK = 512, Z_AV = 640, Z_GQ = 768, Z_GK = 1024, Z_GV = 1280, Z_GR = 1792, Z_GG = 2304,
              Z_MQ = 2336, Z_MK = 2848, Z_MV = 3360, Z_MO = 3872, Z_MI = 4384, Z_MF = 4392, Z_GATE = 4608, DIN = 7472, DIN_MIX = 4400;
constexpr int NSC = 33;
constexpr int LDS_BYTES = 147456;

constexpr size_t AL(size_t x) { return (x + 255) & ~(size_t)255; }
constexpr size_t WS_CTR = 14336;
constexpr size_t WS_CTL_BYTES = 16384;
constexpr size_t WS_XC = 16384;
constexpr size_t WS_MOD = AL(WS_XC + (size_t)NCTX * D * 4);
constexpr size_t WS_ROPE = AL(WS_MOD + (size_t)2 * 5 * NMOD * D * 4);
constexpr size_t WS_WT = AL(WS_ROPE + 128 * 16 * 2 * 4);
constexpr size_t WT_W13A = 0, WT_W2A = WT_W13A + (size_t)2 * DFF * D, WT_WIN = WT_W2A + (size_t)D * DFF, WT_WOUT = WT_WIN + (size_t)ZC * D,
                 WT_WO = WT_WOUT + (size_t)3 * D * 512, WT_W13B = WT_WO + (size_t)D * D, WT_W2B = WT_W13B + (size_t)2 * DFF * D, WT_END = WT_W2B + (size_t)D * DFF;
constexpr size_t WS_XN = AL(WS_WT + WT_END * 2);
constexpr size_t XN_HALF = (size_t)HROWS * D * 2;
constexpr size_t ST_G_ELEMS = (size_t)16 * NSC * 128 * 64, ST_M_ELEMS = (size_t)16 * NSC * 129 * 128;
constexpr size_t WS_STG = WS_XN + XN_HALF;
constexpr size_t WS_STM = AL(WS_STG + ST_G_ELEMS * 2);
constexpr size_t WS_DG = AL(WS_STM + ST_M_ELEMS * 2);
constexpr size_t WS_DM = AL(WS_DG + (size_t)16 * NSC * 64 * 4);
constexpr size_t WS_ST_END = WS_DM + (size_t)16 * NSC * 128 * 4;
constexpr size_t WS_BIG = AL(WS_XN + (size_t)NTOK * D * 2);
constexpr size_t WS_PB = AL(WS_BIG + (size_t)HROWS * ZC * 2);
constexpr size_t PB_STRIDE = (size_t)HROWS * 512;
constexpr size_t WS_AOP = AL(WS_PB + 4 * PB_STRIDE * 2);
constexpr size_t WS_WOPART = AL(WS_AOP + 3 * PB_STRIDE * 2);
constexpr size_t WS_YPART = AL(WS_WOPART + (size_t)2 * 4 * HCTX * D * 4);
constexpr size_t WS_END = AL(WS_YPART + (size_t)3 * HCTX * D * 4);
static_assert(WS_ST_END <= WS_XN + (size_t)NTOK * D * 2, "scan states must fit in the second half of XN");
static_assert((size_t)NTOK * DFF * 2 <= (size_t)HROWS * ZC * 2, "h1 must fit in the z region");

struct Params {
    const float* in[27];
    float* out;
    uchar* ws;
};
enum { I_X = 0, I_C, I_CTX, I_CCTX, I_MODW, I_MODB, I_NORMG, I_F1W13, I_F1W2, I_F2W13, I_F2W2, I_WIN, I_AQN, I_AKN, I_SINK, I_GW2, I_GB, I_GNORM,
       I_CONVW, I_CONVB, I_MIB, I_MFB, I_MNORM, I_WOA, I_WOG, I_WOM, I_WO };

DI unsigned pk2(float lo, float hi) { f32x2 v = {lo, hi}; hbf2 b = __builtin_convertvector(v, hbf2); return __builtin_bit_cast(unsigned, b); }
DI bf16_t f2bf(float x) { return (bf16_t)(pk2(x, 0.f) & 0xffffu); }
DI float bf2f(unsigned b) { return __uint_as_float(b << 16); }
DI float bflo(unsigned w) { return __uint_as_float(w << 16); }
DI float bfhi(unsigned w) { return __uint_as_float(w & 0xffff0000u); }
DI void unpack8(const u32x4 w, float (&f)[8]) { f[0] = bflo(w.x); f[1] = bfhi(w.x); f[2] = bflo(w.y); f[3] = bfhi(w.y); f[4] = bflo(w.z); f[5] = bfhi(w.z); f[6] = bflo(w.w); f[7] = bfhi(w.w); }
DI u32x4 pack8(const float (&f)[8]) { u32x4 w; w.x = pk2(f[0], f[1]); w.y = pk2(f[2], f[3]); w.z = pk2(f[4], f[5]); w.w = pk2(f[6], f[7]); return w; }
DI float sigmoidf_(float x) { return __builtin_amdgcn_rcpf(1.f + __expf(-x)); }
DI float siluf_(float x) { return x * __builtin_amdgcn_rcpf(1.f + __expf(-x)); }
DI float logsigmoidf_(float x) { return fminf(x, 0.f) - __logf(1.f + __expf(-fabsf(x))); }
DI f32x16 zero16() { f32x16 z; for (int i = 0; i < 16; ++i) z[i] = 0.f; return z; }
DI f32x16 mfma32(bf16x8 a, bf16x8 b, f32x16 c) { return __builtin_amdgcn_mfma_f32_32x32x16_bf16(a, b, c, 0, 0, 0); }
DI int crow(int reg, int h) { return (reg & 3) + 8 * (reg >> 2) + 4 * h; }
DI bf16x8 lds_frag(const LAS uchar* p) { return *(const LAS bf16x8*)p; }
DI void block_sync() { __syncthreads(); }
DI int otid() { int t = threadIdx.x; asm volatile("" : "+v"(t)); return t; }

typedef unsigned u32x2v __attribute__((ext_vector_type(2)));
DI float xsum32(float x) { const u32x2v r = __builtin_amdgcn_permlane32_swap(__float_as_uint(x), __float_as_uint(x), false, false); return __uint_as_float(r.x) + __uint_as_float(r.y); }
DI float xmax32(float x) { const u32x2v r = __builtin_amdgcn_permlane32_swap(__float_as_uint(x), __float_as_uint(x), false, false); return fmaxf(__uint_as_float(r.x), __uint_as_float(r.y)); }
template <int CTRL, int RMASK> DI float dpp_add(float v) { return v + __int_as_float(__builtin_amdgcn_update_dpp(0, __float_as_int(v), CTRL, RMASK, 0xf, false)); }
DI float wave_incl_scan(float v) {
    v = dpp_add<0x111, 0xf>(v); v = dpp_add<0x112, 0xf>(v); v = dpp_add<0x114, 0xf>(v); v = dpp_add<0x118, 0xf>(v);
    v = dpp_add<0x142, 0xa>(v); v = dpp_add<0x143, 0xc>(v);
    return v;
}
template <int CTRL> DI float dpp_perm_add(float v) { return v + __int_as_float(__builtin_amdgcn_update_dpp(0, __float_as_int(v), CTRL, 0xf, 0xf, true)); }
DI float quad_sum(float v) { v = dpp_perm_add<0xB1>(v); return dpp_perm_add<0x4E>(v); }
DI float row16_sum(float v) { v = quad_sum(v); v = dpp_perm_add<0x141>(v); return dpp_perm_add<0x140>(v); }
#ifndef WGM_VAL
#define WGM_VAL 4
#endif
constexpr int BM = 256, BK = 64, HALF = 128, HTB = HALF * BK * 2, STAGE_BYTES = 8 * HTB, NXCD = 8, WGM = WGM_VAL;
DI int lds_byte(int r, int c) { const int st = (r >> 4) * 2 + (c >> 5), rr = r & 15, cc = c & 31, ob = rr * 64 + cc * 2; return st * 1024 + (ob ^ (((ob >> 9) & 1) << 5)); }
DI void stage_rc(int b, int& R, int& C) { const int st = b / 1024, sb = b % 1024, swz = sb ^ (((sb >> 9) & 1) << 5); R = (st >> 1) * 16 + swz / 64; C = (st & 1) * 32 + (swz % 64) / 2; }
DI int perm32(int rho) { const int n = rho >> 4, i = rho & 15; return 8 * (i >> 2) + 4 * n + (i & 3); }

struct Unit { int pm, pn, g, ks, rot; const char* a; const char* b; };
#ifndef USE_KROT
#define KROT(x) 0
#else
#define KROT(x) (((x) & 1) ? (((K / BK) >> 1) & ~1) : 0)
#endif
struct Sched {
    int nM, nN, nwg, G, c, ng, K, ld, tail, pm0, nsplit;
    const char* A0; const char* B0; size_t ags, bgs;
    DI void init(int nM_, int nN_, int K_, const void* A, const void* B, int ng_ = 1, size_t ags_ = 0, size_t bgs_ = 0) {
        nM = nM_; nN = nN_; nwg = nM * nN; G = (int)gridDim.x; c = (int)blockIdx.x; ng = ng_; K = K_; ld = K_; tail = 0; pm0 = 0; nsplit = 1; A0 = (const char*)A; B0 = (const char*)B; ags = ags_; bgs = bgs_; }
    DI void init_tail(int pm0_, int nM_, int nN_, int Ksub, int nsplit_, int ld_, const void* A, const void* B) {
        nM = nM_; nN = nN_; nwg = nM * nN * nsplit_; G = (int)gridDim.x; c = (int)blockIdx.x; ng = 1; K = Ksub; ld = ld_; tail = 1; pm0 = pm0_; nsplit = nsplit_; A0 = (const char*)A; B0 = (const char*)B; ags = 0; bgs = 0; }
    DI void init_cm(int pm0_, int nM_, int nN_, int K_, const void* A, const void* B, size_t ags_, size_t bgs_) {
        nM = nM_; nN = nN_; nwg = nM * nN * 3; G = (int)gridDim.x; c = (int)blockIdx.x; ng = 1; K = K_; ld = K_; tail = 2; pm0 = pm0_; nsplit = 1; A0 = (const char*)A; B0 = (const char*)B; ags = ags_; bgs = bgs_; }
    DI bool next(int i, Unit& u) const {
        const size_t tstep = (size_t)BM * ld * 2;
        if (tail == 2) {
            const long L = (long)i * G + c; if (L >= nwg) return false;
            const int g = (int)L % 3, u2 = (int)L / 3;
            u.pm = pm0 + u2 % nM; u.pn = u2 / nM; u.g = g; u.ks = 0; u.rot = 0;
            u.a = A0 + (size_t)g * ags + (size_t)u.pm * tstep; u.b = B0 + (size_t)g * bgs + (size_t)u.pn * tstep; return true;
        }
        if (tail) {
            const long L = (long)i * G + c; if (L >= nwg) return false;
            const int ks = (int)L % nsplit, u2 = (int)L / nsplit;
            u.pm = pm0 + u2 % nM; u.pn = u2 / nM; u.g = 0; u.ks = ks;
            u.rot = KROT(u.pm + u.pn);
            u.a = A0 + (size_t)u.pm * tstep + (size_t)ks * K * 2; u.b = B0 + (size_t)u.pn * tstep + (size_t)ks * K * 2; return true;
        }
        const int round = i / ng, g = i - round * ng;
        const long L = (long)round * G + c; if (L >= nwg) return false;
        int wgid = (int)L; { const int q = nwg / NXCD, r = nwg % NXCD, xcd = wgid % NXCD, off = wgid / NXCD; wgid = (xcd < r ? xcd * (q + 1) : r * (q + 1) + (xcd - r) * q) + off; }
        const int nig = WGM * nN, gid = wgid / nig, fm = gid * WGM, gsz = (nM - fm) < WGM ? (nM - fm) : WGM;
        u.pm = fm + ((wgid % nig) % gsz); u.pn = (wgid % nig) / gsz; u.g = g; u.ks = 0;
        u.rot = KROT(u.pm + u.pn);
        u.a = A0 + (size_t)g * ags + (size_t)u.pm * tstep; u.b = B0 + (size_t)g * bgs + (size_t)u.pn * tstep; return true;
    }
};

template <class Epi>
DI void gemm_phase(LAS uchar* lds, const Sched& S, const Epi& E) {
    const int tid = otid(), wid = __builtin_amdgcn_readfirstlane(tid >> 6), lane = tid & 63, wr = wid >> 2, wc = wid & 3, fr = lane & 15, fq = lane >> 4;
    const int K = S.ld, nt = S.K / BK;
#ifdef GEMM_STAGGER
    { const int sg = (blockIdx.x >> 3) & 3; for (int q = 0; q < sg; ++q) __builtin_amdgcn_s_sleep(64); }
#endif
#define PG8_LAS LAS
    unsigned voffA[2], voffB[2];
#pragma unroll
    for (int i = 0; i < 2; ++i) { int R, C; stage_rc(tid * 16 + i * 8192, R, C); const int Rb = Epi::PERM ? ((R & ~31) + perm32(R & 31)) : R;
        voffA[i] = (unsigned)(R * K + C) * 2u; voffB[i] = (unsigned)(Rb * K + C) * 2u; }
    const size_t kstep = (size_t)(BK * 2);
    const size_t hstep = (size_t)HALF * K * 2;

    const unsigned ldsw = (unsigned)wid * 1024u;
    const int aoff = lds_byte(wr * 64 + fr, fq * 8), boff = lds_byte(wc * 32 + fr, fq * 8);
#define PG8_SA(b, h) (((b) * 2 + (h)) * HTB)
#define PG8_SB(b, h) ((4 + (b) * 2 + (h)) * HTB)
#define PG8_STAGE(bufoff, gbase, voff) do { _Pragma("unroll") for (int _i = 0; _i < 2; ++_i) \
        __builtin_amdgcn_global_load_lds((const unsigned*)((const char*)(gbase) + (voff)[_i]), (PG8_LAS unsigned*)(lds + (bufoff) + ldsw + _i * 8192), 16, 0, 0); } while (0)
#define PG8_LDA(dst, b, h) do { _Pragma("unroll") for (int m = 0; m < 4; ++m) _Pragma("unroll") for (int k = 0; k < 2; ++k) dst[m][k] = *(const PG8_LAS bf16x8*)(lds + PG8_SA(b, h) + aoff + m * 2048 + k * 1024); } while (0)
#define PG8_LDB(dst, b, h) do { _Pragma("unroll") for (int n = 0; n < 2; ++n) _Pragma("unroll") for (int k = 0; k < 2; ++k) dst[n][k] = *(const PG8_LAS bf16x8*)(lds + PG8_SB(b, h) + boff + n * 2048 + k * 1024); } while (0)
#define PG8_MMA(ai, bj, At, Bt) do { __builtin_amdgcn_s_setprio(1); _Pragma("unroll") for (int m = 0; m < 4; ++m) _Pragma("unroll") for (int n = 0; n < 2; ++n) _Pragma("unroll") for (int k = 0; k < 2; ++k) \
        acc[ai][bj][m][n] = __builtin_amdgcn_mfma_f32_16x16x32_bf16(Bt[n][k], At[m][k], acc[ai][bj][m][n], 0, 0, 0); __builtin_amdgcn_s_setprio(0); } while (0)
#define PG8_WAIT_V(n) asm volatile("s_waitcnt vmcnt(" #n ")" ::: "memory")
#define PG8_WAIT_L(n) asm volatile("s_waitcnt lgkmcnt(" #n ")" ::: "memory")
#define PG8_BAR __builtin_amdgcn_s_barrier()
#define PG8_SCHED __builtin_amdgcn_sched_barrier(0)
    Unit cur, nxt; int ui = 0;
    if (!S.next(0, cur)) return;
    f32x4 acc[2][2][4][2];
#pragma unroll
    for (int a = 0; a < 2; ++a)
#pragma unroll
        for (int b = 0; b < 2; ++b)
#pragma unroll
            for (int m = 0; m < 4; ++m)
#pragma unroll
                for (int n = 0; n < 2; ++n) acc[a][b][m][n] = (f32x4){0.f, 0.f, 0.f, 0.f};
    bf16x8 At[4][2], B0[2][2], B1[2][2];
    const char* cA = cur.a; const char* cB = cur.b;
    int rc = cur.rot;
    const size_t r0off = (size_t)rc * kstep;

    PG8_STAGE(PG8_SB(0, 0), cB + r0off, voffB); PG8_STAGE(PG8_SA(0, 0), cA + r0off, voffA); PG8_STAGE(PG8_SB(0, 1), cB + r0off + hstep, voffB); PG8_STAGE(PG8_SA(0, 1), cA + r0off + hstep, voffA);
    if (wr == 1) PG8_BAR;
    PG8_WAIT_V(4); PG8_BAR;
    PG8_STAGE(PG8_SB(1, 0), cB + r0off + kstep, voffB); PG8_STAGE(PG8_SA(1, 0), cA + r0off + kstep, voffA); PG8_STAGE(PG8_SB(1, 1), cB + r0off + hstep + kstep, voffB);
    PG8_WAIT_V(6); PG8_BAR;
    for (;;) {
        const bool has_next = S.next(ui + 1, nxt);
        const char* nA = has_next ? nxt.a : cA; const char* nB = has_next ? nxt.b : cB; const int rn = has_next ? nxt.rot : rc;
        for (int t = 0; t < nt; t += 2) {
            const bool last = (t == nt - 2);
            int t1 = t + rc; t1 = t1 >= nt ? t1 - nt : t1; int t2 = t + 2 + rc; t2 = t2 >= nt ? t2 - nt : t2;
            const char* a1 = cA + (size_t)(t1 + 1) * kstep;
            const char* a2 = last ? nA + (size_t)rn * kstep : cA + (size_t)t2 * kstep; const char* b2 = last ? nB + (size_t)rn * kstep : cB + (size_t)t2 * kstep;
            const char* a3 = a2 + kstep; const char* b3 = b2 + kstep;

            PG8_LDB(B0, 0, 0); PG8_SCHED; PG8_LDA(At, 0, 0); PG8_STAGE(PG8_SA(1, 1), a1 + hstep, voffA);
            PG8_WAIT_L(8); PG8_BAR; PG8_WAIT_L(0); PG8_MMA(0, 0, At, B0); PG8_BAR; PG8_SCHED;
            PG8_LDB(B1, 0, 1); PG8_STAGE(PG8_SB(0, 0), b2, voffB);
            PG8_BAR; PG8_WAIT_L(0); PG8_MMA(0, 1, At, B1); PG8_BAR;
            PG8_LDA(At, 0, 1); PG8_STAGE(PG8_SA(0, 0), a2, voffA);
            PG8_BAR; PG8_WAIT_L(0); PG8_MMA(1, 0, At, B0); PG8_BAR; PG8_SCHED;
            PG8_STAGE(PG8_SB(0, 1), b2 + hstep, voffB);
            PG8_WAIT_V(6); PG8_BAR; PG8_MMA(1, 1, At, B1); PG8_BAR;
            PG8_LDB(B0, 1, 0); PG8_SCHED; PG8_LDA(At, 1, 0); PG8_STAGE(PG8_SA(0, 1), a2 + hstep, voffA);
            PG8_WAIT_L(8); PG8_BAR; PG8_WAIT_L(0); PG8_MMA(0, 0, At, B0); PG8_BAR; PG8_SCHED;
            PG8_LDB(B1, 1, 1); PG8_STAGE(PG8_SB(1, 0), b3, voffB);
            PG8_BAR; PG8_WAIT_L(0); PG8_MMA(0, 1, At, B1); PG8_BAR;
            PG8_LDA(At, 1, 1); PG8_STAGE(PG8_SA(1, 0), a3, voffA);
            PG8_BAR; PG8_WAIT_L(0); PG8_MMA(1, 0, At, B0); PG8_BAR; PG8_SCHED;
            PG8_STAGE(PG8_SB(1, 1), b3 + hstep, voffB);
            PG8_WAIT_V(6); PG8_BAR; PG8_MMA(1, 1, At, B1); PG8_BAR;
        }
        E(acc, cur, wr, wc, fr, fq);
#ifdef PROBE_EPI2
        if constexpr (Epi::IDEM) E(acc, cur, wr, wc, fr, fq);
#endif
        if (!has_next) break;
        if (!(Epi::CHAIN && nxt.g != 0))
#pragma unroll
        for (int a = 0; a < 2; ++a)
#pragma unroll
            for (int b = 0; b < 2; ++b)
#pragma unroll
                for (int m = 0; m < 4; ++m)
#pragma unroll
                    for (int n = 0; n < 2; ++n) acc[a][b][m][n] = (f32x4){0.f, 0.f, 0.f, 0.f};
        cur = nxt; cA = nA; cB = nB; rc = rn; ++ui;
    }
    PG8_WAIT_V(0);
    if (wr == 0) PG8_BAR;
    PG8_BAR;


#undef PG8_SA
#undef PG8_SB
#undef PG8_STAGE
#undef PG8_LDA
#undef PG8_LDB
#undef PG8_MMA
#undef PG8_WAIT_V
#undef PG8_WAIT_L
#undef PG8_BAR
#undef PG8_SCHED
}

DI int panel_grow(int pm, int hf) { return hf < 0 ? pm * 256 : (pm < 64 ? hf * HLAT + pm * 256 : NLAT + hf * HCTX + (pm - 64) * 256); }

struct EpiSwiGLU {
    static constexpr bool PERM = true, IDEM = true, CHAIN = false; static constexpr int NVM = 6;
    bf16_t* H;
    DI void operator()(const f32x4 (&acc)[2][2][4][2], const Unit& u, int wr, int wc, int fr, int fq) const {
        const int row0 = u.pm * BM + wr * 64 + fr, col0 = u.pn * 128 + wc * 32 + 8 * fq;
#pragma unroll
        for (int ai = 0; ai < 2; ++ai)
#pragma unroll
            for (int m = 0; m < 4; ++m) {
                bf16_t* rowp = H + (size_t)(row0 + ai * HALF + m * 16) * DFF + col0;
                const f32x4 a0 = acc[ai][0][m][0], a1 = acc[ai][0][m][1], b0 = acc[ai][1][m][0], b1 = acc[ai][1][m][1];
                u32x4 w;
                w.x = pk2(siluf_(a0[0]) * b0[0], siluf_(a0[1]) * b0[1]); w.y = pk2(siluf_(a0[2]) * b0[2], siluf_(a0[3]) * b0[3]);
                w.z = pk2(siluf_(a1[0]) * b1[0], siluf_(a1[1]) * b1[1]); w.w = pk2(siluf_(a1[2]) * b1[2], siluf_(a1[3]) * b1[3]);
                *(u32x4*)rowp = w;
            }
    }
};
struct EpiResid {
    static constexpr bool PERM = false, IDEM = false, CHAIN = false; static constexpr int NVM = 24;
    const float* in_lat; const float* in_ctx; float* out_lat; float* out_ctx; const float* mod; int mrow; float coef; int hf;
    DI void operator()(const f32x4 (&acc)[2][2][4][2], const Unit& u, int wr, int wc, int fr, int fq) const {
        const int grow0 = panel_grow(u.pm, hf); const bool isctx = grow0 >= NLAT; const int b = isctx ? 4 : grow0 / SEQ;
        const float* mp = mod + (size_t)b * (NMOD * D) + mrow * D;
        const float* ib = isctx ? in_ctx + (size_t)(grow0 - NLAT) * D : in_lat + (size_t)grow0 * D;
        float* ob = isctx ? out_ctx + (size_t)(grow0 - NLAT) * D : out_lat + (size_t)grow0 * D;
        const int r0 = wr * 64 + fr, c0 = u.pn * BM + wc * 32 + 4 * fq;
        f32x4 gv[2][2];
#pragma unroll
        for (int bj = 0; bj < 2; ++bj)
#pragma unroll
            for (int n = 0; n < 2; ++n) gv[bj][n] = *(const f32x4*)(mp + c0 + bj * HALF + n * 16) * coef;
#pragma unroll
        for (int ai = 0; ai < 2; ++ai)
#pragma unroll
            for (int mp = 0; mp < 2; ++mp) {
                f32x4 xi[2][2][2];
#pragma unroll
                for (int mm = 0; mm < 2; ++mm)
#pragma unroll
                    for (int bj = 0; bj < 2; ++bj)
#pragma unroll
                        for (int n = 0; n < 2; ++n) xi[mm][bj][n] = *(const f32x4*)(ib + (size_t)(r0 + ai * HALF + (2 * mp + mm) * 16) * D + c0 + bj * HALF + n * 16);
#pragma unroll
                for (int mm = 0; mm < 2; ++mm)
#pragma unroll
                    for (int bj = 0; bj < 2; ++bj)
#pragma unroll
                        for (int n = 0; n < 2; ++n)
                            *(f32x4*)(ob + (size_t)(r0 + ai * HALF + (2 * mp + mm) * 16) * D + c0 + bj * HALF + n * 16) = xi[mm][bj][n] + gv[bj][n] * acc[ai][bj][2 * mp + mm][n];
            }
    }
};
struct EpiPartial {
    static constexpr bool PERM = false, IDEM = false, CHAIN = false; static constexpr int NVM = 24;
    float* part; const float* mod; int mrow; float coef; int pm0, grp, nsplit, rpg;
    DI void operator()(const f32x4 (&acc)[2][2][4][2], const Unit& u, int wr, int wc, int fr, int fq) const {
        const float* mp = mod + (size_t)4 * (NMOD * D) + mrow * D;
        float* ob = part + ((size_t)(grp * nsplit + u.ks) * rpg + (size_t)(u.pm - pm0) * BM) * D;
        const int r0 = wr * 64 + fr, c0 = u.pn * BM + wc * 32 + 4 * fq;
        f32x4 gv[2][2];
#pragma unroll
        for (int bj = 0; bj < 2; ++bj)
#pragma unroll
            for (int n = 0; n < 2; ++n) gv[bj][n] = *(const f32x4*)(mp + c0 + bj * HALF + n * 16) * coef;
#pragma unroll
        for (int ai = 0; ai < 2; ++ai)
#pragma unroll
            for (int m = 0; m < 4; ++m)
#pragma unroll
                for (int bj = 0; bj < 2; ++bj)
#pragma unroll
                    for (int n = 0; n < 2; ++n)
                        *(f32x4*)(ob + (size_t)(r0 + ai * HALF + m * 16) * D + c0 + bj * HALF + n * 16) = gv[bj][n] * acc[ai][bj][m][n];
    }
};
struct EpiZ {
    static constexpr bool PERM = true, IDEM = true, CHAIN = false; static constexpr int NVM = 12;
    bf16_t* Z;
    DI void operator()(const f32x4 (&acc)[2][2][4][2], const Unit& u, int wr, int wc, int fr, int fq) const {
        const int row0 = u.pm * BM + wr * 64 + fr, col0 = u.pn * BM + wc * 32 + 8 * fq; const bool sg = u.pn >= (Z_GATE / BM);
#pragma unroll
        for (int ai = 0; ai < 2; ++ai)
#pragma unroll
            for (int m = 0; m < 4; ++m) {
                bf16_t* rowp = Z + (size_t)(row0 + ai * HALF + m * 16) * ZC + col0;
#pragma unroll
                for (int bj = 0; bj < 2; ++bj) {
                    f32x4 v0 = acc[ai][bj][m][0], v1 = acc[ai][bj][m][1];
                    if (sg) {
#pragma unroll
                        for (int k = 0; k < 4; ++k) { v0[k] = sigmoidf_(v0[k]); v1[k] = sigmoidf_(v1[k]); } }
                    u32x4 w; w.x = pk2(v0[0], v0[1]); w.y = pk2(v0[2], v0[3]); w.z = pk2(v1[0], v1[1]); w.w = pk2(v1[2], v1[3]);
                    *(u32x4*)(rowp + bj * HALF) = w;
                }
            }
    }
};
struct EpiGated {
    static constexpr bool PERM = true, IDEM = false, CHAIN = false; static constexpr int NVM = 24;
    float* G; const bf16_t* Z; int pm0;
    DI void operator()(const f32x4 (&acc)[2][2][4][2], const Unit& u, int wr, int wc, int fr, int fq) const {
        const int row0 = u.pm * BM + wr * 64 + fr, col0 = u.pn * BM + wc * 32 + 8 * fq;
#pragma unroll
        for (int ai = 0; ai < 2; ++ai) {
            u32x4 gw[4][2];
#pragma unroll
            for (int m = 0; m < 4; ++m)
#pragma unroll
                for (int bj = 0; bj < 2; ++bj) gw[m][bj] = *(const u32x4*)(Z + (size_t)(row0 + ai * HALF + m * 16) * ZC + Z_GATE + u.g * D + col0 + bj * HALF);
#pragma unroll
            for (int m = 0; m < 4; ++m)
#pragma unroll
                for (int bj = 0; bj < 2; ++bj) {
                    float gf[8]; unpack8(gw[m][bj], gf);
                    const f32x4 v0 = acc[ai][bj][m][0], v1 = acc[ai][bj][m][1];
                    float* gp = G + ((size_t)u.g * HCTX + (size_t)(row0 - pm0 * BM + ai * HALF + m * 16)) * D + col0 + bj * HALF;
                    *(f32x4*)gp = (f32x4){gf[0] * v0[0], gf[1] * v0[1], gf[2] * v0[2], gf[3] * v0[3]};
                    *(f32x4*)(gp + 4) = (f32x4){gf[4] * v1[0], gf[5] * v1[1], gf[6] * v1[2], gf[7] * v1[3]};
                }
        }
    }
};
struct EpiMerge {
    static constexpr bool PERM = true, IDEM = false, CHAIN = false; static constexpr int NVM = 24;
    bf16_t* Y; const bf16_t* Z;
    DI void operator()(const f32x4 (&acc)[2][2][4][2], const Unit& u, int wr, int wc, int fr, int fq) const {
        const int row0 = u.pm * BM + wr * 64 + fr, col0 = u.pn * BM + wc * 32 + 8 * fq;
#pragma unroll
        for (int ai = 0; ai < 2; ++ai) {
            u32x4 gw[4][2], yw[4][2];
#pragma unroll
            for (int m = 0; m < 4; ++m)
#pragma unroll
                for (int bj = 0; bj < 2; ++bj) {
                    const size_t row = (size_t)(row0 + ai * HALF + m * 16);
                    gw[m][bj] = *(const u32x4*)(Z + row * ZC + Z_GATE + u.g * D + col0 + bj * HALF);
                    yw[m][bj] = u.g ? *(const u32x4*)(Y + row * D + col0 + bj * HALF) : (u32x4){0u, 0u, 0u, 0u};
                }
#pragma unroll
            for (int m = 0; m < 4; ++m)
#pragma unroll
                for (int bj = 0; bj < 2; ++bj) {
                    const size_t row = (size_t)(row0 + ai * HALF + m * 16);
                    float gf[8], yf[8]; unpack8(gw[m][bj], gf); unpack8(yw[m][bj], yf);
                    const f32x4 v0 = acc[ai][bj][m][0], v1 = acc[ai][bj][m][1];
#pragma unroll
                    for (int k = 0; k < 4; ++k) { yf[k] += gf[k] * v0[k]; yf[4 + k] += gf[4 + k] * v1[k]; }
                    *(u32x4*)(Y + row * D + col0 + bj * HALF) = pack8(yf);
                }
        }
    }
};

DI float wave_sum(float v) {
    v = row16_sum(v);
    const int iv = __float_as_int(v);
    return (__int_as_float(__builtin_amdgcn_readlane(iv, 0)) + __int_as_float(__builtin_amdgcn_readlane(iv, 16))) + (__int_as_float(__builtin_amdgcn_readlane(iv, 32)) + __int_as_float(__builtin_amdgcn_readlane(iv, 48)));
}

DI int wsrc(int np, int mode) {
    if (mode == 1) { const int pn = np >> 8, bj = (np >> 7) & 1, cc = np & 127; return bj * DFF + pn * 128 + cc; }
    if (mode == 2) return np < DIN_MIX ? np : (np < Z_GATE ? -1 : np - (Z_GATE - DIN_MIX));
    return np;
}
DI void conv_tile(LAS uchar* lds, const float* W, int K, int N, bf16_t* WT, int NP, int mode, int item) {
    LAS float* tile = (LAS float*)lds;
    const int ntn = NP / 128, kb = item / ntn, nb = item % ntn, k0 = kb * 64, n0 = nb * 128, tid = otid();
    { const int nl = tid & 127, kr0 = tid >> 7; const int src = wsrc(n0 + nl, mode);
      const int srcc = src >= 0 ? src : 0; const float vsel = src >= 0 ? 1.f : 0.f; float wv[16];
#pragma unroll
      for (int i = 0; i < 16; ++i) wv[i] = W[(size_t)(k0 + kr0 + 4 * i) * N + srcc];
#pragma unroll
      for (int i = 0; i < 16; ++i) tile[(kr0 + 4 * i) * 129 + nl] = wv[i] * vsel; }
    block_sync();
    { const int nl = tid >> 2, ks = (tid & 3) * 16; float f[8], g[8];
#pragma unroll
      for (int j = 0; j < 8; ++j) { f[j] = tile[(ks + j) * 129 + nl]; g[j] = tile[(ks + 8 + j) * 129 + nl]; }
      bf16_t* dst = WT + (size_t)(n0 + nl) * K + k0 + ks;
      *(u32x4*)dst = pack8(f); *(u32x4*)(dst + 8) = pack8(g); }
    block_sync();
}
DI void phase_convert(LAS uchar* lds, const Params& P, int layer) {
    bf16_t* WT = (bf16_t*)(P.ws + WS_WT);
    constexpr int I13 = (D / 64) * (2 * DFF / 128), I2 = (DFF / 64) * (D / 128), IIN = (D / 64) * (ZC / 128), IOUT = (512 / 64) * (D / 128), IO = (D / 64) * (D / 128);
    constexpr int NIT = 2 * I13 + 2 * I2 + IIN + 3 * IOUT + IO;
    for (int it = blockIdx.x; it < NIT; it += gridDim.x) {
        int r = it;
        if (r < I13) { conv_tile(lds, P.in[I_F1W13] + (size_t)layer * D * 2 * DFF, D, 2 * DFF, WT + WT_W13A, 2 * DFF, 1, r); continue; } r -= I13;
        if (r < I13) { conv_tile(lds, P.in[I_F2W13] + (size_t)layer * D * 2 * DFF, D, 2 * DFF, WT + WT_W13B, 2 * DFF, 1, r); continue; } r -= I13;
        if (r < I2) { conv_tile(lds, P.in[I_F1W2] + (size_t)layer * DFF * D, DFF, D, WT + WT_W2A, D, 0, r); continue; } r -= I2;
        if (r < I2) { conv_tile(lds, P.in[I_F2W2] + (size_t)layer * DFF * D, DFF, D, WT + WT_W2B, D, 0, r); continue; } r -= I2;
        if (r < IIN) { conv_tile(lds, P.in[I_WIN] + (size_t)layer * D * DIN, D, DIN, WT + WT_WIN, ZC, 2, r); continue; } r -= IIN;
        if (r < IOUT) { conv_tile(lds, P.in[I_WOA] + (size_t)layer * 512 * D, 512, D, WT + WT_WOUT, D, 0, r); continue; } r -= IOUT;
        if (r < IOUT) { conv_tile(lds, P.in[I_WOG] + (size_t)layer * 512 * D, 512, D, WT + WT_WOUT + (size_t)D * 512, D, 0, r); continue; } r -= IOUT;
        if (r < IOUT) { conv_tile(lds, P.in[I_WOM] + (size_t)layer * 512 * D, 512, D, WT + WT_WOUT + (size_t)2 * D * 512, D, 0, r); continue; } r -= IOUT;
        conv_tile(lds, P.in[I_WO] + (size_t)layer * D * D, D, D, WT + WT_WO, D, 0, r);
    }
}

DI void phase_mods(LAS uchar* lds, const Params& P) {
    LAS float* sc = (LAS float*)lds;
    LAS float* red = sc + 5 * D;
    const int tid = otid();
    for (int idx = tid; idx < 5 * D; idx += 512) { const int r = idx >> 10, k = idx & 1023; const float v = r < 4 ? P.in[I_C][r * D + k] : P.in[I_CCTX][k]; sc[idx] = siluf_(v); }
    block_sync();
    float* MOD = (float*)(P.ws + WS_MOD);
    const int col = tid & 63, kq = tid >> 6;
    for (int it = blockIdx.x; it < 2 * 144; it += gridDim.x) {
        const int l = it / 144, cb = it % 144;
        const float* w = P.in[I_MODW] + (size_t)l * D * (NMOD * D) + cb * 64 + col;
        float a0 = 0.f, a1 = 0.f, a2 = 0.f, a3 = 0.f, a4 = 0.f;
#pragma unroll 16
        for (int k = kq * 128; k < kq * 128 + 128; ++k) { const float wv = w[(size_t)k * (NMOD * D)]; a0 += sc[k] * wv; a1 += sc[D + k] * wv; a2 += sc[2 * D + k] * wv; a3 += sc[3 * D + k] * wv; a4 += sc[4 * D + k] * wv; }
        red[(kq * 5 + 0) * 64 + col] = a0; red[(kq * 5 + 1) * 64 + col] = a1; red[(kq * 5 + 2) * 64 + col] = a2; red[(kq * 5 + 3) * 64 + col] = a3; red[(kq * 5 + 4) * 64 + col] = a4;
        block_sync();
        if (tid < 320) { const int r = tid >> 6; float s = P.in[I_MODB][(size_t)l * NMOD * D + cb * 64 + col];
#pragma unroll
            for (int q = 0; q < 8; ++q) s += red[(q * 5 + r) * 64 + col];
            MOD[((size_t)l * 5 + r) * (NMOD * D) + cb * 64 + col] = s; }
        block_sync();
    }
}
__device__ const double ROPE_INV[16] = {1.0, 0.5623413251903491, 0.31622776601683794, 0.1778279410038923, 0.1, 0.05623413251903491, 0.031622776601683791, 0.01778279410038923,
                                        0.01, 0.005623413251903491, 0.0031622776601683794, 0.001778279410038923, 0.001, 0.0005623413251903491, 0.00031622776601683794, 0.0001778279410038923};
DI void phase_rope(const Params& P) {
    float* tab = (float*)(P.ws + WS_ROPE);
    for (int idx = blockIdx.x * 512 + otid(); idx < 128 * 16; idx += gridDim.x * 512) {
        const int p = idx >> 4, f = idx & 15;
        const float inv = (float)ROPE_INV[f]; const float angf = (float)p * inv;
        double rev = (double)angf * 0.15915494309189535; rev -= floor(rev);
        tab[idx * 2] = __builtin_amdgcn_cosf((float)rev); tab[idx * 2 + 1] = __builtin_amdgcn_sinf((float)rev);
    }
}

struct CtxRed { const float* part; int nsplit, rpg; float* xc_wb; };
DI void ctx_reduce_row(const CtxRed& R, int cr, int lane, f32x4 (&v)[4]) {
    const size_t base = ((size_t)(cr / R.rpg) * R.nsplit * R.rpg + (size_t)(cr % R.rpg)) * D;
    for (int ks = 0; ks < R.nsplit; ++ks) {
        const float* pr = R.part + base + (size_t)ks * R.rpg * D;
#pragma unroll
        for (int q = 0; q < 4; ++q) v[q] += *(const f32x4*)(pr + q * 256 + lane * 4);
    }
#pragma unroll
    for (int q = 0; q < 4; ++q) *(f32x4*)(R.xc_wb + (size_t)cr * D + q * 256 + lane * 4) = v[q];
}
DI void phase_adaln(const Params& P, int layer, int j, const float* src_lat, const float* src_ctx, bf16_t* dst, int nrows, int hf, const CtxRed red, int extra_lo, int extra_hi) {
    const int tid = otid(), lane = tid & 63, wave = tid >> 6;
    const float* MOD = (const float*)(P.ws + WS_MOD) + (size_t)layer * 5 * NMOD * D;
    const float* gain = P.in[I_NORMG] + ((size_t)layer * 3 + j) * D;
    const int stride = gridDim.x * 8;
    auto grow_of = [&](int lr) -> int { return hf < 0 ? lr : (lr < HLAT ? hf * HLAT + lr : NLAT + hf * HCTX + (lr - HLAT)); };
    auto xrow_of = [&](int gr) -> const float* { return gr < NLAT ? src_lat + (size_t)gr * D : src_ctx + (size_t)(gr - NLAT) * D; };
    int lr = blockIdx.x * 8 + wave;
    f32x4 vn[4];
    if (lr < nrows) { const float* xr = xrow_of(grow_of(lr));
#pragma unroll
        for (int q = 0; q < 4; ++q) vn[q] = *(const f32x4*)(xr + q * 256 + lane * 4); }
    f32x4 gq[4], s0q[4], s1q[4]; int bcur = -1;
#pragma unroll
    for (int q = 0; q < 4; ++q) gq[q] = *(const f32x4*)(gain + q * 256 + lane * 4);
    for (; lr < nrows; lr += stride) {
        const int gr = grow_of(lr);
        const int b = gr < NLAT ? gr / SEQ : 4;
        if (b != bcur) {
            const float* sh = MOD + (size_t)b * NMOD * D + (3 * j) * D; const float* scl = sh + D;
#pragma unroll
            for (int q = 0; q < 4; ++q) { s0q[q] = *(const f32x4*)(sh + q * 256 + lane * 4); s1q[q] = *(const f32x4*)(scl + q * 256 + lane * 4) + 1.f; }
            bcur = b;
        }
        f32x4 v[4]; float ss = 0.f;
#pragma unroll
        for (int q = 0; q < 4; ++q) v[q] = vn[q];
        if (lr + stride < nrows) { const float* xr = xrow_of(grow_of(lr + stride));
#pragma unroll
            for (int q = 0; q < 4; ++q) vn[q] = *(const f32x4*)(xr + q * 256 + lane * 4); }
        if (red.part != nullptr && gr >= NLAT) ctx_reduce_row(red, gr - NLAT, lane, v);
#pragma unroll
        for (int q = 0; q < 4; ++q) ss += v[q][0] * v[q][0] + v[q][1] * v[q][1] + v[q][2] * v[q][2] + v[q][3] * v[q][3];
        ss = wave_sum(ss);
        const float rstd = rsqrtf(ss * (1.f / D) + 1e-6f);
#pragma unroll
        for (int q = 0; q < 4; ++q) {
            const int c = q * 256 + lane * 4;
            const f32x4 y = v[q] * rstd * gq[q] * s1q[q] + s0q[q];
            u32x2 w; w.x = pk2(y[0], y[1]); w.y = pk2(y[2], y[3]);
            *(u32x2*)(dst + (size_t)lr * D + c) = w;
        }
    }
    if (red.part != nullptr)
        for (int cr = extra_lo + blockIdx.x * 8 + wave; cr < extra_hi; cr += gridDim.x * 8) {
            f32x4 v[4];
#pragma unroll
            for (int q = 0; q < 4; ++q) v[q] = *(const f32x4*)(src_ctx + (size_t)cr * D + q * 256 + lane * 4);
            ctx_reduce_row(red, cr, lane, v);
        }
}

constexpr int KS_STRIDE = 144, VT_STRIDE = 264, AT_KS = 0, AT_VT = 128 * KS_STRIDE;
DI void attn_item(LAS uchar* lds, const Params& P, int layer, const bf16_t* z, bf16_t* aout, int item) {
    const int tid = otid(), wave = __builtin_amdgcn_readfirstlane(tid >> 6), lane = tid & 63, r = lane & 31, hh = lane >> 5;
    const bool isctx = item >= 256;
    int lb, kvh, nb;
    if (!isctx) { lb = item >> 7; kvh = (item >> 6) & 1; nb = item & 63; } else { const int it = item - 256; lb = it >> 2; kvh = (it >> 1) & 1; nb = it & 1; }
    const int qbase = isctx ? HLAT + lb * CTXL + nb * 128 : lb * SEQ + nb * 128;
    const int g = wave >> 1, hq = kvh * 4 + g, qi0 = (wave & 1) * 64;
    const float* rope = (const float*)(P.ws + WS_ROPE);
    const float* qn = P.in[I_AQN] + layer * 64; const float* kn = P.in[I_AKN] + layer * 64;
    const float sink2 = P.in[I_SINK][layer * 8 + hq] * 1.4426950408889634f;
    LAS uchar* Ks = lds + AT_KS; LAS uchar* Vt = lds + AT_VT;

    auto kb_valid = [&](int kb) -> bool { if (kb >= 3) return kb < 5; if (isctx) return false; const int kblk = nb + kb - 1; return kblk >= 0 && kblk < SEQ / 128; };
    auto kb_row0 = [&](int kb) -> int { return kb >= 3 ? HLAT + lb * CTXL + (kb - 3) * 128 : lb * SEQ + (nb + kb - 1) * 128; };
    const int key = tid >> 2, dq = tid & 3;
    u32x4 pk0, pk1, pv0, pv1;
#define ATT_LOAD(kb_) do { const bf16_t* zr_ = z + (size_t)(kb_row0(kb_) + key) * ZC; \
        pk0 = *(const u32x4*)(zr_ + Z_AK + kvh * 64 + dq * 8); pk1 = *(const u32x4*)(zr_ + Z_AK + kvh * 64 + 32 + dq * 8); \
        pv0 = *(const u32x4*)(zr_ + Z_AV + kvh * 64 + dq * 16); pv1 = *(const u32x4*)(zr_ + Z_AV + kvh * 64 + dq * 16 + 8); } while (0)
    int kb = 0; while (!kb_valid(kb)) ++kb;
    ATT_LOAD(kb);
    float kn1[8], kn2[8];
#pragma unroll
    for (int j = 0; j < 8; ++j) { kn1[j] = kn[dq * 8 + j]; kn2[j] = kn[32 + dq * 8 + j]; }

    bf16x8 Qf[2][4];
#pragma unroll
    for (int qt = 0; qt < 2; ++qt) {
        const int qi = qi0 + qt * 32 + r; const bf16_t* qp = z + (size_t)(qbase + qi) * ZC + Z_AQ + hq * 64 + 8 * hh;
        float f[4][8]; float ss = 0.f;
#pragma unroll
        for (int s = 0; s < 4; ++s) { unpack8(*(const u32x4*)(qp + 16 * s), f[s]);
#pragma unroll
            for (int j = 0; j < 8; ++j) ss += f[s][j] * f[s][j]; }
        ss = xsum32(ss);
        const float rstd = rsqrtf(ss * (1.f / 64.f) + 1e-6f);
#pragma unroll
        for (int s = 0; s < 4; ++s)
#pragma unroll
            for (int j = 0; j < 8; ++j) f[s][j] *= rstd * qn[16 * s + 8 * hh + j];
        if (!isctx) {
            const int pos = nb * 128 + qi;
#pragma unroll
            for (int s = 0; s < 2; ++s) {
                const float* tp = rope + ((size_t)((s == 0 ? (pos >> 6) : (pos & 63)) * 16 + 8 * hh)) * 2;
#pragma unroll
                for (int j = 0; j < 8; ++j) { const float c = tp[2 * j], sn = tp[2 * j + 1], x1 = f[s][j], x2 = f[s + 2][j]; f[s][j] = x1 * c - x2 * sn; f[s + 2][j] = x1 * sn + x2 * c; }
            }
        }
#pragma unroll
        for (int s = 0; s < 4; ++s) {
#pragma unroll
            for (int j = 0; j < 8; ++j) f[s][j] *= 0.125f * 1.4426950408889634f;
            Qf[qt][s] = __builtin_bit_cast(bf16x8, pack8(f[s])); }
    }
    f32x16 O[2][2]; float mrun[2], lrun[2];
#pragma unroll
    for (int qt = 0; qt < 2; ++qt) { O[qt][0] = zero16(); O[qt][1] = zero16(); mrun[qt] = sink2; lrun[qt] = 1.f; }

    while (kb < 5) {
        const bool kctx = kb >= 3;
        block_sync();
        {
            float x1[8], x2[8]; unpack8(pk0, x1); unpack8(pk1, x2);
            float ss = 0.f;
#pragma unroll
            for (int j = 0; j < 8; ++j) ss += x1[j] * x1[j] + x2[j] * x2[j];
            ss = quad_sum(ss);
            const float rstd = rsqrtf(ss * (1.f / 64.f) + 1e-6f);
#pragma unroll
            for (int j = 0; j < 8; ++j) { x1[j] *= rstd * kn1[j]; x2[j] *= rstd * kn2[j]; }
            if (!kctx) {
                const int pos = (nb + kb - 1) * 128 + key;
                const float* tp = rope + ((size_t)((dq < 2 ? (pos >> 6) : (pos & 63)) * 16 + (dq & 1) * 8)) * 2;
#pragma unroll
                for (int j = 0; j < 8; ++j) { const float c = tp[2 * j], sn = tp[2 * j + 1], a = x1[j], b = x2[j]; x1[j] = a * c - b * sn; x2[j] = a * sn + b * c; }
            }
            *(LAS u32x4*)(Ks + key * KS_STRIDE + dq * 16) = pack8(x1);
            *(LAS u32x4*)(Ks + key * KS_STRIDE + 64 + dq * 16) = pack8(x2);
            const unsigned vw[8] = {pv0.x, pv0.y, pv0.z, pv0.w, pv1.x, pv1.y, pv1.z, pv1.w};
#pragma unroll
            for (int i = 0; i < 8; ++i) {
                *(LAS bf16_t*)(Vt + (dq * 16 + 2 * i) * VT_STRIDE + key * 2) = (bf16_t)(vw[i] & 0xffffu);
                *(LAS bf16_t*)(Vt + (dq * 16 + 2 * i + 1) * VT_STRIDE + key * 2) = (bf16_t)(vw[i] >> 16); }
        }
        int kbn = kb + 1; while (kbn < 5 && !kb_valid(kbn)) ++kbn;
        if (kbn < 5) ATT_LOAD(kbn);
        block_sync();
#pragma unroll 1
        for (int kt = 0; kt < 4; ++kt) {
            const int q32a = (wave & 1) * 2;
            bool skip[2], diag[2];
#pragma unroll
            for (int qt = 0; qt < 2; ++qt) { const int q32 = q32a + qt; skip[qt] = (kb == 0 && kt < q32) || (kb == 2 && kt > q32); diag[qt] = (kb == 0 || kb == 2) && kt == q32; }
            if (skip[0] && skip[1]) continue;
            bf16x8 Kf[4];
#pragma unroll
            for (int s = 0; s < 4; ++s) Kf[s] = lds_frag(Ks + (kt * 32 + r) * KS_STRIDE + (16 * s + 8 * hh) * 2);
            bf16x8 Vf[2][2];
#pragma unroll
            for (int dt = 0; dt < 2; ++dt)
#pragma unroll
                for (int s = 0; s < 2; ++s) {
                    const LAS uchar* vp = Vt + (dt * 32 + r) * VT_STRIDE + (kt * 32 + 16 * s + 4 * hh) * 2;
                    const u32x2 lo = *(const LAS u32x2*)vp, hi = *(const LAS u32x2*)(vp + 16);
                    u32x4 w; w.x = lo.x; w.y = lo.y; w.z = hi.x; w.w = hi.y; Vf[dt][s] = __builtin_bit_cast(bf16x8, w); }
#pragma unroll
            for (int qt = 0; qt < 2; ++qt) {
                if (skip[qt]) continue;
                f32x16 S = zero16();
#pragma unroll
                for (int s = 0; s < 4; ++s) S = mfma32(Kf[s], Qf[qt][s], S);
                if (diag[qt]) {
#pragma unroll
                    for (int i = 0; i < 16; ++i) { const bool ok = (kb == 0) ? (crow(i, hh) >= r) : (crow(i, hh) <= r); S[i] = ok ? S[i] : -1e30f; }
                }
                float mx = S[0];
#pragma unroll
                for (int i = 1; i < 16; ++i) mx = fmaxf(mx, S[i]);
                mx = xmax32(mx);
                const float mnew = fmaxf(mrun[qt], mx), alpha = __builtin_amdgcn_exp2f(mrun[qt] - mnew);
                float ps = 0.f;
#pragma unroll
                for (int i = 0; i < 16; ++i) { S[i] = __builtin_amdgcn_exp2f(S[i] - mnew); ps += S[i]; }
                ps = xsum32(ps);
                lrun[qt] = lrun[qt] * alpha + ps; mrun[qt] = mnew;
#pragma unroll
                for (int i = 0; i < 16; ++i) { O[qt][0][i] *= alpha; O[qt][1][i] *= alpha; }
#pragma unroll
                for (int s = 0; s < 2; ++s) {
                    u32x4 pw; pw.x = pk2(S[8 * s], S[8 * s + 1]); pw.y = pk2(S[8 * s + 2], S[8 * s + 3]); pw.z = pk2(S[8 * s + 4], S[8 * s + 5]); pw.w = pk2(S[8 * s + 6], S[8 * s + 7]);
                    const bf16x8 pf = __builtin_bit_cast(bf16x8, pw);
                    O[qt][0] = mfma32(Vf[0][s], pf, O[qt][0]); O[qt][1] = mfma32(Vf[1][s], pf, O[qt][1]);
                }
            }
        }
        kb = kbn;
    }
#undef ATT_LOAD
#pragma unroll
    for (int qt = 0; qt < 2; ++qt) {
        const float invl = __builtin_amdgcn_rcpf(lrun[qt]); const int qi = qi0 + qt * 32 + r;
        bf16_t* op = aout + (size_t)(qbase + qi) * 512 + hq * 64;
#pragma unroll
        for (int dt = 0; dt < 2; ++dt)
#pragma unroll
            for (int g4 = 0; g4 < 4; ++g4) {
                u32x2 w; w.x = pk2(O[qt][dt][4 * g4] * invl, O[qt][dt][4 * g4 + 1] * invl); w.y = pk2(O[qt][dt][4 * g4 + 2] * invl, O[qt][dt][4 * g4 + 3] * invl);
                *(u32x2*)(op + dt * 32 + 8 * g4 + 4 * hh) = w; }
    }
    block_sync();
}

template <int DK, bool ML>
DI void scan_item(LAS uchar* lds, const Params& P, int layer, const bf16_t* z, int ch, int s, int mode, bf16_t* stbuf, float* dbuf, bf16_t* pb) {
    const bool full = mode != 0, loadst = mode == 1, wrst = mode != 1;
    constexpr int QSS = (DK + 8) * 2, TS = 144, NT = DK / 64, NE = ML ? 129 : 128;
    constexpr int O_QS = 0, O_KS = 17408, O_KST = 34816, O_VT = 53248, O_ST = 71680, O_BF = 106496, O_MISC = 122880;
    LAS uchar* QS = lds + O_QS; LAS uchar* KS = lds + O_KS; LAS uchar* KST = lds + O_KST; LAS uchar* VT = lds + O_VT; LAS uchar* ST = lds + O_ST;
    LAS float* BF = (LAS float*)(lds + O_BF);
    LAS float* bsc = (LAS float*)(lds + O_MISC); LAS float* gi = bsc + 64; LAS float* nvec = bsc + 128;
    LAS bf16_t* nb = (LAS bf16_t*)(lds + O_MISC + 1536);
    const int tid = otid(), wave = __builtin_amdgcn_readfirstlane(tid >> 6), lane = tid & 63, r = lane & 31, hh = lane >> 5;
    const int dir = ch & 1, h = (ch >> 1) & 3, lb = ch >> 3;
    int base_row, t0;
    if (s == 0) { base_row = HLAT + lb * CTXL; t0 = dir ? CTXL - 1 : 0; }
    else { const int sc = dir ? (32 - s) : (s - 1); base_row = lb * SEQ; t0 = sc * 256 + (dir ? 255 : 0); }
    const int tdir = dir ? -1 : 1;
    bf16_t* gst = stbuf + ((size_t)ch * NSC + s) * NE * DK;
    const int eb = wave & 3, dbase = (wave >> 2) * NT, ib = wave >> 2;
#define VT_OFF(e_, blk_) ((e_) * TS + ((((blk_) ^ ((e_) >> 4)) & 7) << 4))
#define KT_OFF(d_, blk_) ((d_) * TS + ((((blk_) ^ ((d_) >> 3)) & 7) << 4))
    f32x16 Sacc[NT]; float dsum[NT];
#pragma unroll
    for (int ti = 0; ti < NT; ++ti) { Sacc[ti] = zero16(); dsum[ti] = 0.f; }
    int ncur = 0;
    const float gate_fb = ML ? P.in[I_MFB][layer * 8 + dir * 4 + h] : 0.f, gate_ib = ML ? P.in[I_MIB][layer * 8 + dir * 4 + h] : 0.f;
    LAS float* W2S = (LAS float*)(lds + O_MISC + 2048);
    if constexpr (!ML) {
        const float* w2g = P.in[I_GW2] + (size_t)layer * 2 * 16 * 256 + dir * 16 * 256 + h * 64;
        for (int idx = tid; idx < 1024; idx += 512) W2S[idx] = w2g[(idx >> 6) * 256 + (idx & 63)];
        if (tid < 64) W2S[1024 + tid] = P.in[I_GB][(size_t)layer * 512 + dir * 256 + h * 64 + tid];
        block_sync();
    }
    const int j = tid >> 3, dseg = tid & 7;
    const bf16_t* cq = (const bf16_t*)(P.ws + WS_AOP) + PB_STRIDE;
    u32x4 rq0, rq1, rk0, rk1, rv0, rv1, rg0, rg1; float rmf = 0.f, rmi = 0.f;
    rq0 = rq1 = rk0 = rk1 = rv0 = rv1 = rg0 = rg1 = (u32x4){0u, 0u, 0u, 0u};
#define SCAN_LOAD(cc_) do { \
        const size_t row_ = (size_t)(base_row + t0 + tdir * ((cc_) * 64 + j)); \
        const bf16_t* zl_ = z + (size_t)(base_row + t0 + tdir * ((cc_) * 64 + lane)) * ZC; \
        if constexpr (!ML) { \
            const bf16_t* zp_ = z + row_ * ZC; \
            rg0 = *(const u32x4*)(zl_ + Z_GG + dir * 16); rg1 = *(const u32x4*)(zl_ + Z_GG + dir * 16 + 8); \
            if (full) rq0 = *(const u32x4*)(zp_ + Z_GQ + h * 64 + dseg * 8); rk0 = *(const u32x4*)(zp_ + Z_GK + h * 64 + dseg * 8); \
            rv0 = *(const u32x4*)(zp_ + Z_GV + h * 128 + dseg * 16); rv1 = *(const u32x4*)(zp_ + Z_GV + h * 128 + dseg * 16 + 8); \
        } else { \
            const bf16_t* qp_ = cq + row_ * 512 + h * 128 + dseg * 16; \
            if (full) { rq0 = *(const u32x4*)qp_; rq1 = *(const u32x4*)(qp_ + 8); } rk0 = *(const u32x4*)(qp_ + PB_STRIDE); rk1 = *(const u32x4*)(qp_ + PB_STRIDE + 8); \
            const bf16_t* vp_ = z + row_ * ZC + Z_MV + h * 128 + dseg * 16; rv0 = *(const u32x4*)vp_; rv1 = *(const u32x4*)(vp_ + 8); \
            if (wave == 0) { rmf = bf2f(zl_[Z_MF + dir * 4 + h]); rmi = bf2f(zl_[Z_MI + dir * 4 + h]); } \
        } } while (0)
    SCAN_LOAD(0);
    if (loadst) {
        for (int idx = tid; idx < 128 * DK / 8; idx += 512) { const int e = idx / (DK / 8), d8 = idx % (DK / 8); *(LAS u32x4*)(ST + e * QSS + d8 * 16) = *(const u32x4*)(gst + (size_t)e * DK + d8 * 8); }
        if (ML && tid < 128) { const bf16_t nraw = gst[(size_t)128 * DK + tid]; nvec[tid] = bf2f(nraw); nb[tid] = nraw; }
        block_sync();
#pragma unroll
        for (int ti = 0; ti < NT; ++ti)
#pragma unroll
            for (int i = 0; i < 16; ++i) Sacc[ti][i] = bf2f(*(const LAS bf16_t*)(ST + (eb * 32 + crow(i, hh)) * QSS + ((dbase + ti) * 32 + r) * 2));
    } else {
        if (ML && tid < 128) { nvec[tid] = 0.f; nb[tid] = 0; }
        if (full) { for (int idx = tid; idx < 128 * QSS / 16; idx += 512) *(LAS u32x4*)(ST + idx * 16) = (u32x4){0u, 0u, 0u, 0u}; }
    }
#pragma unroll 1
    for (int cc = 0; cc < 4; ++cc) {
        if constexpr (!ML) {
            float gf[16];
            { float t8[8]; unpack8(rg0, t8);
#pragma unroll
              for (int k = 0; k < 8; ++k) gf[k] = t8[k];
              unpack8(rg1, t8);
#pragma unroll
              for (int k = 0; k < 8; ++k) gf[8 + k] = t8[k]; }
            float la[8];
            { const f32x4 b0 = *(const LAS f32x4*)(W2S + 1024 + wave * 8), b1 = *(const LAS f32x4*)(W2S + 1024 + wave * 8 + 4);
#pragma unroll
              for (int k = 0; k < 4; ++k) { la[k] = b0[k]; la[4 + k] = b1[k]; } }
#pragma unroll
            for (int rr = 0; rr < 16; ++rr) {
                const f32x4 w0 = *(const LAS f32x4*)(W2S + rr * 64 + wave * 8), w1 = *(const LAS f32x4*)(W2S + rr * 64 + wave * 8 + 4);
#pragma unroll
                for (int k = 0; k < 4; ++k) { la[k] += w0[k] * gf[rr]; la[4 + k] += w1[k] * gf[rr]; }
            }
#pragma unroll
            for (int k = 0; k < 8; ++k) la[k] = logsigmoidf_(la[k]) * 0.0625f;
#pragma unroll
            for (int k = 0; k < 8; ++k) la[k] = wave_incl_scan(la[k]);
            *(LAS f32x4*)(BF + lane * 64 + wave * 8) = (f32x4){la[0], la[1], la[2], la[3]};
            *(LAS f32x4*)(BF + lane * 64 + wave * 8 + 4) = (f32x4){la[4], la[5], la[6], la[7]};
        } else {
            if (wave == 0) {
                const float mf = rmf + gate_fb;
                const float mi = rmi + gate_ib;
                float x = logsigmoidf_(mf);
                x = wave_incl_scan(x);
                bsc[lane] = x; gi[lane] = mi;
            }
        }
        if (full && cc > 0) {
#pragma unroll
            for (int ti = 0; ti < NT; ++ti)
#pragma unroll
                for (int i = 0; i < 16; ++i) *(LAS bf16_t*)(ST + (eb * 32 + crow(i, hh)) * QSS + ((dbase + ti) * 32 + r) * 2) = f2bf(Sacc[ti][i]);
        }
        block_sync();
        if constexpr (!ML) {
            float bj[8], qf[8], kf[8];
#pragma unroll
            for (int k = 0; k < 8; ++k) bj[k] = BF[j * 64 + dseg * 8 + k];
            unpack8(rk0, kf);
#pragma unroll
            for (int k = 0; k < 8; ++k) kf[k] *= __expf(-bj[k]);
            const u32x4 kw = pack8(kf);
            if (full) {
                unpack8(rq0, qf);
#pragma unroll
                for (int k = 0; k < 8; ++k) qf[k] *= 0.125f * __expf(bj[k]);
                *(LAS u32x4*)(QS + j * QSS + dseg * 16) = pack8(qf);
                *(LAS u32x4*)(KS + j * QSS + dseg * 16) = kw;
            }
            const unsigned kwv[4] = {kw.x, kw.y, kw.z, kw.w};
#pragma unroll
            for (int k = 0; k < 4; ++k) {
                *(LAS bf16_t*)(KST + KT_OFF(dseg * 8 + 2 * k, j >> 3) + (j & 7) * 2) = (bf16_t)(kwv[k] & 0xffffu);
                *(LAS bf16_t*)(KST + KT_OFF(dseg * 8 + 2 * k + 1, j >> 3) + (j & 7) * 2) = (bf16_t)(kwv[k] >> 16); }
        } else {
            const float bjv = bsc[j], eq = __expf(bjv), ek = __expf(gi[j] - bjv);
#pragma unroll
            for (int part = 0; part < 2; ++part) {
                const int c8 = dseg * 16 + part * 8; float qf[8], kf[8];
                unpack8(part ? rk1 : rk0, kf);
#pragma unroll
                for (int k = 0; k < 8; ++k) kf[k] *= ek;
                const u32x4 w = pack8(kf);
                if (full) {
                    unpack8(part ? rq1 : rq0, qf);
#pragma unroll
                    for (int k = 0; k < 8; ++k) qf[k] *= eq;
                    *(LAS u32x4*)(QS + j * QSS + c8 * 2) = pack8(qf);
                    *(LAS u32x4*)(KS + j * QSS + c8 * 2) = w;
                }
                const unsigned wv[4] = {w.x, w.y, w.z, w.w};
#pragma unroll
                for (int k = 0; k < 4; ++k) {
                    *(LAS bf16_t*)(KST + KT_OFF(c8 + 2 * k, j >> 3) + (j & 7) * 2) = (bf16_t)(wv[k] & 0xffffu);
                    *(LAS bf16_t*)(KST + KT_OFF(c8 + 2 * k + 1, j >> 3) + (j & 7) * 2) = (bf16_t)(wv[k] >> 16); }
            }
        }
        {
            const unsigned vw[8] = {rv0.x, rv0.y, rv0.z, rv0.w, rv1.x, rv1.y, rv1.z, rv1.w};
#pragma unroll
            for (int k = 0; k < 8; ++k) {
                *(LAS bf16_t*)(VT + VT_OFF(dseg * 16 + 2 * k, j >> 3) + (j & 7) * 2) = (bf16_t)(vw[k] & 0xffffu);
                *(LAS bf16_t*)(VT + VT_OFF(dseg * 16 + 2 * k + 1, j >> 3) + (j & 7) * 2) = (bf16_t)(vw[k] >> 16); }
        }
        if (cc < 3) SCAN_LOAD(cc + 1);
        block_sync();
        if (full) {
            f32x16 o = zero16(), o2 = zero16(), dn = zero16();
            const int erow = eb * 32 + r;
#pragma unroll
            for (int jb = 0; jb < 2; ++jb) {
                if (jb <= ib) {
                    f32x16 x = zero16();
#pragma unroll 4
                    for (int k = 0; k < DK / 16; ++k) x = mfma32(lds_frag(KS + (jb * 32 + r) * QSS + (16 * k + 8 * hh) * 2), lds_frag(QS + (ib * 32 + r) * QSS + (16 * k + 8 * hh) * 2), x);
                    if (jb == ib) {
#pragma unroll
                        for (int i = 0; i < 16; ++i) x[i] = (crow(i, hh) <= r) ? x[i] : 0.f; }
#pragma unroll
                    for (int sx = 0; sx < 2; ++sx) {
                        u32x4 pw; pw.x = pk2(x[8 * sx], x[8 * sx + 1]); pw.y = pk2(x[8 * sx + 2], x[8 * sx + 3]); pw.z = pk2(x[8 * sx + 4], x[8 * sx + 5]); pw.w = pk2(x[8 * sx + 6], x[8 * sx + 7]);
                        const u32x2 lo = *(const LAS u32x2*)(VT + VT_OFF(erow, jb * 4 + 2 * sx) + 8 * hh), hi = *(const LAS u32x2*)(VT + VT_OFF(erow, jb * 4 + 2 * sx + 1) + 8 * hh);
                        u32x4 vb; vb.x = lo.x; vb.y = lo.y; vb.z = hi.x; vb.w = hi.y;
                        o = mfma32(__builtin_bit_cast(bf16x8, pw), __builtin_bit_cast(bf16x8, vb), o);
                        if (ML) dn = mfma32(__builtin_bit_cast(bf16x8, pw), __builtin_bit_cast(bf16x8, (u32x4){0x3F803F80u, 0x3F803F80u, 0x3F803F80u, 0x3F803F80u}), dn);
                    }
                }
            }
#pragma unroll 4
            for (int k = 0; k < DK / 16; ++k) {
                const bf16x8 qf = lds_frag(QS + (ib * 32 + r) * QSS + (16 * k + 8 * hh) * 2);
                o2 = mfma32(qf, lds_frag(ST + erow * QSS + (16 * k + 8 * hh) * 2), o2);
                if (ML) dn = mfma32(qf, *(const LAS bf16x8*)(nb + ncur * 128 + 16 * k + 8 * hh), dn);
            }
#pragma unroll
            for (int i = 0; i < 16; ++i) {
                const int itok = ib * 32 + crow(i, hh); float val = o[i] + o2[i];
                if (ML) val = val * __builtin_amdgcn_rcpf(fmaxf(fabsf(dn[i]), 1.f));
                const size_t row = (size_t)(base_row + t0 + tdir * (cc * 64 + itok));
                pb[((size_t)dir * HROWS + row) * 512 + h * 128 + eb * 32 + r] = f2bf(val);
            }
        }
        {
            const int erow = eb * 32 + r;
#pragma unroll
            for (int ti = 0; ti < NT; ++ti) {
                const int drow = (dbase + ti) * 32 + r;
#pragma unroll
                for (int k = 0; k < 4; ++k) Sacc[ti] = mfma32(lds_frag(VT + VT_OFF(erow, 2 * k + hh)), lds_frag(KST + KT_OFF(drow, 2 * k + hh)), Sacc[ti]);
                const float bl = ML ? bsc[63] : BF[63 * 64 + drow]; const float dec = __expf(bl);
#pragma unroll
                for (int i = 0; i < 16; ++i) Sacc[ti][i] *= dec;
                dsum[ti] += bl;
            }
            if (ML && tid < 128) {
                float nn = nvec[ncur * 128 + tid];
#pragma unroll
                for (int q = 0; q < 8; ++q) { float kf[8]; unpack8(*(const LAS u32x4*)(KST + tid * TS + q * 16), kf);
#pragma unroll
                    for (int k = 0; k < 8; ++k) nn += kf[k]; }
                const float nnew = nn * __expf(bsc[63]); nvec[(ncur ^ 1) * 128 + tid] = nnew; nb[(ncur ^ 1) * 128 + tid] = f2bf(nnew);
            }
        }
        ncur ^= 1;
        block_sync();
    }
    if (wrst) {
#pragma unroll
        for (int ti = 0; ti < NT; ++ti) {
            const int db = dbase + ti;
#pragma unroll
            for (int i = 0; i < 16; ++i) gst[(size_t)(eb * 32 + crow(i, hh)) * DK + db * 32 + r] = f2bf(Sacc[ti][i]);
            if (eb == 0 && hh == 0) dbuf[((size_t)ch * NSC + s) * DK + db * 32 + r] = __expf(dsum[ti]);
        }
        if (ML && tid < 128) gst[(size_t)128 * DK + tid] = f2bf(nvec[ncur * 128 + tid]);
    }
    block_sync();
#undef SCAN_LOAD
#undef VT_OFF
#undef KT_OFF
}

DI void phase_conv_qk(const Params& P, int layer) {
    const bf16_t* z = (const bf16_t*)(P.ws + WS_BIG); bf16_t* cq = (bf16_t*)(P.ws + WS_AOP) + PB_STRIDE;
    const float* cw = P.in[I_CONVW] + (size_t)layer * 5 * 1024; const float* cbp = P.in[I_CONVB] + (size_t)layer * 1024;
    const int gt = blockIdx.x * 512 + otid(), cch = (gt & 127) * 8, rstride = gridDim.x * 4;
    float wt[5][8], bias[8];
    { const f32x4 b0 = *(const f32x4*)(cbp + cch), b1 = *(const f32x4*)(cbp + cch + 4);
#pragma unroll
      for (int k = 0; k < 4; ++k) { bias[k] = b0[k]; bias[4 + k] = b1[k]; } }
#pragma unroll
    for (int tau = 0; tau < 5; ++tau) { const f32x4 w0 = *(const f32x4*)(cw + tau * 1024 + cch), w1 = *(const f32x4*)(cw + tau * 1024 + cch + 4);
#pragma unroll
        for (int k = 0; k < 4; ++k) { wt[tau][k] = w0[k]; wt[tau][4 + k] = w1[k]; } }
    const float sc = cch >= 512 ? 0.08838834764831845f : 1.f;
    bf16_t* outp = cq + (size_t)(cch >= 512 ? 1 : 0) * PB_STRIDE + (cch & 511);
    u32x4 xn[5];
#define CONV_LOAD(lr_) do { const int t_ = (lr_) < HLAT ? ((lr_) & (SEQ - 1)) : (((lr_) - HLAT) & (CTXL - 1)); const int sl_ = (lr_) < HLAT ? SEQ : CTXL; \
        _Pragma("unroll") for (int tau = 0; tau < 5; ++tau) { const int tt_ = t_ + tau - 2; const int rr_ = (tt_ >= 0 && tt_ < sl_) ? (lr_) + tau - 2 : (lr_); \
            xn[tau] = *(const u32x4*)(z + (size_t)rr_ * ZC + Z_MQ + cch); } } while (0)
    int lr = gt >> 7;
    if (lr < HROWS) CONV_LOAD(lr);
    for (; lr < HROWS; lr += rstride) {
        u32x4 xc[5];
#pragma unroll
        for (int tau = 0; tau < 5; ++tau) xc[tau] = xn[tau];
        if (lr + rstride < HROWS) CONV_LOAD(lr + rstride);
        const int t = lr < HLAT ? (lr & (SEQ - 1)) : ((lr - HLAT) & (CTXL - 1)), seqlen = lr < HLAT ? SEQ : CTXL;
        float a[8];
#pragma unroll
        for (int k = 0; k < 8; ++k) a[k] = bias[k];
#pragma unroll
        for (int tau = 0; tau < 5; ++tau) {
            const int tt = t + tau - 2; const float vs = (tt >= 0 && tt < seqlen) ? 1.f : 0.f;
            float xf[8]; unpack8(xc[tau], xf);
#pragma unroll
            for (int k = 0; k < 8; ++k) a[k] += wt[tau][k] * (xf[k] * vs);
        }
#pragma unroll
        for (int k = 0; k < 8; ++k) a[k] = siluf_(a[k]) * sc;
        *(u32x4*)(outp + (size_t)lr * 512) = pack8(a);
    }
#undef CONV_LOAD
}

DI void phase_scan_carry(const Params& P) {
    constexpr int NG = 16 * 128 * 16, NM = 16 * 129 * 32;
    for (int idx = blockIdx.x * 512 + otid(); idx < NG + NM; idx += gridDim.x * 512) {
        bf16_t* st; const float* dp; size_t sstride; int dstride;
        if (idx < NG) { const int ch = idx >> 11, rem = idx & 2047, e = rem >> 4, d4 = rem & 15;
            st = (bf16_t*)(P.ws + WS_STG) + (size_t)ch * NSC * 128 * 64 + e * 64 + d4 * 4; sstride = 128 * 64; dp = (const float*)(P.ws + WS_DG) + (size_t)ch * NSC * 64 + d4 * 4; dstride = 64; }
        else { const int i2 = idx - NG, ch = i2 / (129 * 32), rem = i2 % (129 * 32), e = rem >> 5, d4 = rem & 31;
            st = (bf16_t*)(P.ws + WS_STM) + (size_t)ch * NSC * 129 * 128 + e * 128 + d4 * 4; sstride = 129 * 128; dp = (const float*)(P.ws + WS_DM) + (size_t)ch * NSC * 128 + d4 * 4; dstride = 128; }
        f32x4 carry = {0.f, 0.f, 0.f, 0.f};
#pragma unroll 1
        for (int s0 = 0; s0 < NSC - 1; s0 += 8) {
            u32x2 L[8]; f32x4 dc[8];
#pragma unroll
            for (int k = 0; k < 8; ++k) { L[k] = *(const u32x2*)(st + (size_t)(s0 + k) * sstride); dc[k] = *(const f32x4*)(dp + (s0 + k) * dstride); }
#pragma unroll
            for (int k = 0; k < 8; ++k) {
                u32x2 w; w.x = pk2(carry[0], carry[1]); w.y = pk2(carry[2], carry[3]);
                *(u32x2*)(st + (size_t)(s0 + k) * sstride) = w;
                const f32x4 l = {bflo(L[k].x), bfhi(L[k].x), bflo(L[k].y), bfhi(L[k].y)};
                carry = dc[k] * carry + l;
            }
        }
        { u32x2 w; w.x = pk2(carry[0], carry[1]); w.y = pk2(carry[2], carry[3]); *(u32x2*)(st + (size_t)(NSC - 1) * sstride) = w; }
    }
}

DI void phase_merge_prep(const Params& P, int layer, int nrows) {
    const int tid = otid(), lane = tid & 63, wave = tid >> 6, c = lane * 8;
    const bf16_t* z = (const bf16_t*)(P.ws + WS_BIG); const bf16_t* pb = (const bf16_t*)(P.ws + WS_PB); bf16_t* aop = (bf16_t*)(P.ws + WS_AOP);
    const int stride = gridDim.x * 8;
    int lr = blockIdx.x * 8 + wave;
    u32x4 na[2], nbv[2], ng[2];
#define PREP_LOAD(row_) do { _Pragma("unroll") for (int mx = 0; mx < 2; ++mx) { \
        na[mx] = *(const u32x4*)(pb + (size_t)(2 * mx) * PB_STRIDE + (size_t)(row_) * 512 + c); nbv[mx] = *(const u32x4*)(pb + (size_t)(2 * mx + 1) * PB_STRIDE + (size_t)(row_) * 512 + c); \
        ng[mx] = *(const u32x4*)(z + (size_t)(row_) * ZC + (mx ? Z_MO : Z_GR) + c); } } while (0)
    float gnr[2][8];
#pragma unroll
    for (int mx = 0; mx < 2; ++mx) { const float* gn = (mx ? P.in[I_MNORM] : P.in[I_GNORM]) + layer * 128 + (c & 127);
#pragma unroll
        for (int k = 0; k < 8; ++k) gnr[mx][k] = gn[k]; }
    if (lr < nrows) PREP_LOAD(lr);
    for (; lr < nrows; lr += stride) {
        u32x4 ca[2], cb[2], cg[2];
#pragma unroll
        for (int mx = 0; mx < 2; ++mx) { ca[mx] = na[mx]; cb[mx] = nbv[mx]; cg[mx] = ng[mx]; }
        if (lr + stride < nrows) PREP_LOAD(lr + stride);
#pragma unroll
        for (int mx = 0; mx < 2; ++mx) {
            float a[8], b[8], gt[8];
            unpack8(ca[mx], a); unpack8(cb[mx], b); unpack8(cg[mx], gt);
            float ss = 0.f;
#pragma unroll
            for (int k = 0; k < 8; ++k) { a[k] += b[k]; ss += a[k] * a[k]; }
            ss = row16_sum(ss);
            const float rstd = rsqrtf(ss * (1.f / 128.f) + 1e-6f);
#pragma unroll
            for (int k = 0; k < 8; ++k) a[k] = a[k] * rstd * gnr[mx][k] * (mx ? sigmoidf_(gt[k]) : siluf_(gt[k]));
            *(u32x4*)(aop + (size_t)(1 + mx) * PB_STRIDE + (size_t)lr * 512 + c) = pack8(a);
        }
    }
#undef PREP_LOAD
}


#include <vector>


#define XB_TMO      128
#define XB_XCNT(j)  (256  + 64 * (j))
#define XB_XSUB(j)  (1280 + 64 * (j))
#define XB_XGEN(j)  (2304 + 64 * (j))
#define XB_TOP      3328
#define XB_TOPGEN   3392
#define XCD_BAR_WORDS 3456
#define XB_SPIN_CAP (1u << 18)

__device__ __forceinline__ unsigned xb_ld(unsigned* p)              { return __hip_atomic_load(p, __ATOMIC_RELAXED, __HIP_MEMORY_SCOPE_AGENT); }
__device__ __forceinline__ unsigned xb_add(unsigned* p, unsigned v) { return __hip_atomic_fetch_add(p, v, __ATOMIC_RELAXED, __HIP_MEMORY_SCOPE_AGENT); }
__device__ __forceinline__ unsigned xb_xcc_id() { return (unsigned)__builtin_amdgcn_s_getreg((3 << 11) | 20) & 0xFu; }
#define XB_SPIN(cond, bar) do { unsigned _sp = 0; while (cond) { __builtin_amdgcn_s_sleep(1); \
    if ((++_sp & 255u) == 0u) { if (xb_ld(&(bar)[XB_TMO])) break; if (_sp > XB_SPIN_CAP) { atomicAdd(&(bar)[XB_TMO], 1u); break; } } } } while (0)

struct XcdBarrier {
    unsigned* bar; unsigned x;
    volatile LAS unsigned* st;
};

__device__ __forceinline__ XcdBarrier xcd_barrier_post(unsigned* bar, volatile LAS unsigned* st) {
    XcdBarrier b; b.bar = bar; b.x = xb_xcc_id(); b.st = st;
    if (threadIdx.x == 0) (void)xb_add(&bar[XB_XCNT(b.x)], 1u);
    return b;
}
__device__ __forceinline__ void xcd_barrier_complete(unsigned* bar, unsigned x, unsigned& nloc, unsigned& nx) {
    const unsigned G = gridDim.x * gridDim.y * gridDim.z;
    unsigned sum, cnt, mine, sp = 0u;
    for (;;) {
        sum = 0u; cnt = 0u; mine = 0u;
#pragma unroll
        for (unsigned j = 0; j < 16; ++j) { const unsigned c = xb_ld(&bar[XB_XCNT(j)]); sum += c; cnt += (c > 0u) ? 1u : 0u; mine = (j == x) ? c : mine; }
        if (sum == G) break;
        __builtin_amdgcn_s_sleep(1);
        if ((++sp & 255u) == 0u) { if (xb_ld(&bar[XB_TMO])) break; if (sp > XB_SPIN_CAP) { atomicAdd(&bar[XB_TMO], 1u); break; } }
    }
    nloc = mine > 0u ? mine : 1u; nx = cnt > 0u ? cnt : 1u;
}

__device__ __forceinline__ void xcd_barrier(const XcdBarrier& b) {
    asm volatile("s_waitcnt vmcnt(0)" ::: "memory");
    __syncthreads();
    if (threadIdx.x == 0) {
        unsigned* bar = b.bar;
        __builtin_amdgcn_s_waitcnt(0);
        unsigned nloc = b.st[0], nx = b.st[1];
        if (nloc == 0u) { xcd_barrier_complete(bar, b.x, nloc, nx); b.st[0] = nloc; b.st[1] = nx; }
        const unsigned old = xb_add(&bar[XB_XSUB(b.x)], 1u);
        const unsigned gen = old / nloc;
        if (old + 1u == (gen + 1u) * nloc) {
            __builtin_amdgcn_fence(__ATOMIC_RELEASE, "agent");
            asm volatile("s_waitcnt vmcnt(0)" ::: "memory");
            const unsigned og = xb_add(&bar[XB_TOP], 1u);
            const unsigned tg = og / nx;
            if (og + 1u == (tg + 1u) * nx) xb_add(&bar[XB_TOPGEN], 1u);
            else XB_SPIN(xb_ld(&bar[XB_TOPGEN]) == tg, bar);
            __builtin_amdgcn_fence(__ATOMIC_ACQUIRE, "agent");
            xb_add(&bar[XB_XGEN(b.x)], 1u);
            asm volatile("s_waitcnt vmcnt(0)" ::: "memory");
        } else {
            XB_SPIN(xb_ld(&bar[XB_XGEN(b.x)]) == gen, bar);
            __builtin_amdgcn_fence(__ATOMIC_ACQUIRE, "agent");
            asm volatile("s_waitcnt vmcnt(0)" ::: "memory");
        }
    }
    __syncthreads();
}

DI int next_item(unsigned* ctr, LAS uchar* lds) {
    volatile LAS unsigned* w = (volatile LAS unsigned*)(lds + LDS_BYTES - 8);
    __syncthreads();
    if (threadIdx.x == 0) *w = atomicAdd(ctr, 1u);
    __syncthreads();
    return (int)*w;
}
#ifdef PROBE_TS
#define SYNC(cls) do { grid.sync(); if (blockIdx.x == 0 && threadIdx.x == 0) { const unsigned long long t_ = __builtin_amdgcn_s_memrealtime(); ((unsigned long long*)P.ws)[16 + (cls)] += t_ - ((unsigned long long*)P.ws)[0]; ((unsigned long long*)P.ws)[0] = t_; } } while (0)
#else
#ifdef PROBE_SYNC2
#define SYNC(cls) do { grid.sync(); grid.sync(); } while (0)
#else
#define SYNC(cls) xcd_barrier(xb)
#endif
#endif
#ifdef PROBE_MIX2
#define MIXREP 2
#else
#define MIXREP 1
#endif
__global__ void __launch_bounds__(512, 2) hybrid_fwd(Params P) {
    extern __shared__ __attribute__((aligned(16))) uchar shm[];
    LAS uchar* lds = (LAS uchar*)shm;
    cg::grid_group grid = cg::this_grid();
    { volatile LAS unsigned* st = (volatile LAS unsigned*)(lds + LDS_BYTES - 16); if (threadIdx.x == 0) { st[0] = 0u; st[1] = 0u; st[2] = 0u; st[3] = 0u; } }
    __syncthreads();
    XcdBarrier xb = xcd_barrier_post((unsigned*)P.ws, (volatile LAS unsigned*)(lds + LDS_BYTES - 16));
    uchar* ws = P.ws;
    bf16_t* WT = (bf16_t*)(ws + WS_WT); bf16_t* XN = (bf16_t*)(ws + WS_XN); bf16_t* BIG = (bf16_t*)(ws + WS_BIG); bf16_t* AOP = (bf16_t*)(ws + WS_AOP); bf16_t* PB = (bf16_t*)(ws + WS_PB);
    float* XC = (float*)(ws + WS_XC); const float* MOD = (const float*)(ws + WS_MOD);
#ifdef PROBE_TS
    if (blockIdx.x == 0 && threadIdx.x == 0) { for (int i = 0; i < 32; ++i) ((unsigned long long*)P.ws)[16 + i] = 0ull; ((unsigned long long*)P.ws)[0] = __builtin_amdgcn_s_memrealtime(); }
#endif
#ifdef PROBE_MODS
    phase_mods(lds, P);
#endif
    phase_mods(lds, P); phase_rope(P);
    for (int layer = 0; layer < 2; ++layer) {
        const bool last = layer == 1;
        const float* xl = layer == 0 ? P.in[I_X] : P.out; const float* xc = layer == 0 ? P.in[I_CTX] : XC;
        const float* modl = MOD + (size_t)layer * 5 * NMOD * D;
        const CtxRed nored{nullptr, 0, 1, XC}, w2red{(const float*)PB, DFF / 256, NCTX, XC}, wored{(const float*)(ws + WS_WOPART), D / 256, HCTX, XC};
#ifdef PROBE_CONV
        phase_convert(lds, P, layer);
#endif
        phase_convert(lds, P, layer);
        if (P.ws == nullptr) grid.sync();
        if (layer == 0) SYNC(0);
#ifdef PROBE_ADALN
        phase_adaln(P, layer, 0, xl, xc, XN, NTOK, -1, layer ? w2red : nored, 0, 0);
#endif
        phase_adaln(P, layer, 0, xl, xc, XN, NTOK, -1, layer ? w2red : nored, 0, 0);
        SYNC(1);
#ifdef PROBE_G13
        { Sched S; S.init(NTOK / BM, 2 * DFF / BM, D, XN, WT + WT_W13A); EpiSwiGLU E{BIG}; gemm_phase(lds, S, E); }
#endif
        { Sched S; S.init(NTOK / BM, 2 * DFF / BM, D, XN, WT + WT_W13A); EpiSwiGLU E{BIG}; gemm_phase(lds, S, E); }
        SYNC(2);
#ifdef PROBE_G2
        { Sched S; S.init(NTOK / BM, D / BM, DFF, BIG, WT + WT_W2A); EpiResid E{xl, xc, P.out, XC, modl, 2, 0.25f, -1}; gemm_phase(lds, S, E); }
        { Sched S; S.init(NTOK / BM, D / BM, DFF, BIG, WT + WT_W2A); EpiResid E{P.out, XC, P.out, XC, modl, 2, 0.25f, -1}; gemm_phase(lds, S, E); }
#else
        { Sched S; S.init(NLAT / BM, D / BM, DFF, BIG, WT + WT_W2A); EpiResid E{xl, xc, P.out, XC, modl, 2, 0.5f, -1}; gemm_phase(lds, S, E); }
        { Sched S; S.init_tail(NLAT / BM, NCTX / BM, D / BM, 256, DFF / 256, DFF, BIG, WT + WT_W2A); EpiPartial E{(float*)PB, modl, 2, 0.5f, NLAT / BM, 0, DFF / 256, NCTX}; gemm_phase(lds, S, E); }
#endif
        SYNC(3);
        const int nMh = last ? HLAT / BM : HROWS / BM;
        for (int hf = 0; hf < 2; ++hf) {
#ifdef PROBE_ADALN
            phase_adaln(P, layer, 1, P.out, hf == 0 ? xc : (const float*)XC, XN, HROWS, hf, hf == 0 ? w2red : nored, HCTX, hf == 0 ? NCTX : 0);
#endif
            phase_adaln(P, layer, 1, P.out, hf == 0 ? xc : (const float*)XC, XN, HROWS, hf, hf == 0 ? w2red : nored, HCTX, hf == 0 ? NCTX : 0);
            SYNC(1);
#ifdef PROBE_GIN
            { Sched S; S.init(HROWS / BM, ZC / BM, D, XN, WT + WT_WIN); EpiZ E{BIG}; gemm_phase(lds, S, E); }
#endif
            { Sched S; S.init(HROWS / BM, ZC / BM, D, XN, WT + WT_WIN); EpiZ E{BIG}; gemm_phase(lds, S, E); }
            SYNC(4);
            {
                unsigned* ctra = (unsigned*)(ws + WS_CTR) + ((layer * 2 + hf) * 2 + 0) * 64 + 32;
                if (blockIdx.x & 1) phase_conv_qk(P, layer);
                for (int i2 = next_item(ctra, lds); i2 < 256; i2 = next_item(ctra, lds)) attn_item(lds, P, layer, BIG, AOP, i2);
                if (!(blockIdx.x & 1)) phase_conv_qk(P, layer);
            }
            SYNC(4);
            {
                unsigned* ctr = (unsigned*)(ws + WS_CTR) + ((layer * 2 + hf) * 2 + 0) * 64;
                const int natt = last ? 0 : 8, mode0 = last ? 0 : 2;
                for (int i2 = next_item(ctr, lds); i2 < 1024 + natt; i2 = next_item(ctr, lds)) {
                    if (i2 < natt) attn_item(lds, P, layer, BIG, AOP, 256 + i2);
                    else if (i2 < natt + 512) { const int i3 = i2 - natt; scan_item<128, true>(lds, P, layer, BIG, i3 >> 5, i3 & 31, (i3 & 31) ? 0 : mode0, (bf16_t*)(ws + WS_STM), (float*)(ws + WS_DM), PB + 2 * PB_STRIDE); }
                    else { const int i3 = i2 - natt - 512; scan_item<64, false>(lds, P, layer, BIG, i3 >> 5, i3 & 31, (i3 & 31) ? 0 : mode0, (bf16_t*)(ws + WS_STG), (float*)(ws + WS_DG), PB); }
                }
            }
            SYNC(5);
            phase_scan_carry(P);
            SYNC(6);
            {
                unsigned* ctr = (unsigned*)(ws + WS_CTR) + ((layer * 2 + hf) * 2 + 1) * 64;
                for (int i2 = next_item(ctr, lds); i2 < 1024; i2 = next_item(ctr, lds)) {
                    if (i2 < 512) scan_item<128, true>(lds, P, layer, BIG, i2 >> 5, 1 + (i2 & 31), 1, (bf16_t*)(ws + WS_STM), nullptr, PB + 2 * PB_STRIDE);
                    else scan_item<64, false>(lds, P, layer, BIG, (i2 - 512) >> 5, 1 + (i2 & 31), 1, (bf16_t*)(ws + WS_STG), nullptr, PB);
                }
            }
            SYNC(7);
#ifdef PROBE_PREP
            phase_merge_prep(P, layer, last ? HLAT : HROWS);
#endif
            phase_merge_prep(P, layer, last ? HLAT : HROWS);
            SYNC(8);
#ifdef PROBE_GMERGE
            { Sched S; S.init(nMh, D / BM, 512, AOP, WT + WT_WOUT, 3, PB_STRIDE * 2, (size_t)D * 512 * 2); EpiMerge E{XN, BIG}; gemm_phase(lds, S, E); }
#endif
            { Sched S; S.init(nMh, D / BM, 512, AOP, WT + WT_WOUT, 3, PB_STRIDE * 2, (size_t)D * 512 * 2); EpiMerge E{XN, BIG}; gemm_phase(lds, S, E); }
            SYNC(9);
#ifdef PROBE_GWO
            { Sched S; S.init(nMh, D / BM, D, XN, WT + WT_WO); EpiResid E{P.out, XC, P.out, XC, modl, 5, 0.5f, hf}; gemm_phase(lds, S, E); }
            { Sched S; S.init(nMh, D / BM, D, XN, WT + WT_WO); EpiResid E{P.out, XC, P.out, XC, modl, 5, 0.5f, hf}; gemm_phase(lds, S, E); }
#else
            { Sched S; S.init(HLAT / BM, D / BM, D, XN, WT + WT_WO); EpiResid E{P.out, XC, P.out, XC, modl, 5, 1.0f, hf}; gemm_phase(lds, S, E); }
            if (!last) { Sched S; S.init_tail(HLAT / BM, HCTX / BM, D / BM, 256, D / 256, D, XN, WT + WT_WO); EpiPartial E{(float*)(ws + WS_WOPART), modl, 5, 1.0f, HLAT / BM, hf, D / 256, HCTX}; gemm_phase(lds, S, E); }
#endif
            SYNC(10);
        }
        const int nrows2 = last ? NLAT : NTOK;
#ifdef PROBE_ADALN
        phase_adaln(P, layer, 2, P.out, XC, XN, nrows2, -1, last ? nored : wored, 0, 0);
#endif
        phase_adaln(P, layer, 2, P.out, XC, XN, nrows2, -1, last ? nored : wored, 0, 0);
        SYNC(1);
#ifdef PROBE_G13
        { Sched S; S.init(nrows2 / BM, 2 * DFF / BM, D, XN, WT + WT_W13B); EpiSwiGLU E{BIG}; gemm_phase(lds, S, E); }
#endif
        { Sched S; S.init(nrows2 / BM, 2 * DFF / BM, D, XN, WT + WT_W13B); EpiSwiGLU E{BIG}; gemm_phase(lds, S, E); }
        SYNC(2);
#ifdef PROBE_G2
        { Sched S; S.init(nrows2 / BM, D / BM, DFF, BIG, WT + WT_W2B); EpiResid E{P.out, XC, P.out, XC, modl, 8, 0.25f, -1}; gemm_phase(lds, S, E); }
        { Sched S; S.init(nrows2 / BM, D / BM, DFF, BIG, WT + WT_W2B); EpiResid E{P.out, XC, P.out, XC, modl, 8, 0.25f, -1}; gemm_phase(lds, S, E); }
#else
        { Sched S; S.init(NLAT / BM, D / BM, DFF, BIG, WT + WT_W2B); EpiResid E{P.out, XC, P.out, XC, modl, 8, 0.5f, -1}; gemm_phase(lds, S, E); }
        if (!last) { Sched S; S.init_tail(NLAT / BM, NCTX / BM, D / BM, 256, DFF / 256, DFF, BIG, WT + WT_W2B); EpiPartial E{(float*)PB, modl, 8, 0.5f, NLAT / BM, 0, DFF / 256, NCTX}; gemm_phase(lds, S, E); }
#endif
        SYNC(3);
    }
#ifdef PROBE_TS
    SYNC(11); SYNC(12);
    if (blockIdx.x == 0) {
        const unsigned long long* ts = (const unsigned long long*)P.ws + 16;
        const float ta = (float)ts[PROBE_A] * 0.01f, tb = (float)ts[PROBE_B] * 0.01f;
        if (threadIdx.x == 0) P.out[0] += ta;
        for (int i = 1 + threadIdx.x; i < 1 + (1 << 22); i += 512) P.out[i] += tb * 0.01f;
    }
#endif
}

extern "C" void kernel_launch(void* const* d_in, const int* in_sizes, int n_in, void* d_out, int out_size, void* d_ws, size_t ws_size, hipStream_t stream) {
    static int grid_blocks = 0;
    if (!grid_blocks) {
        int dev = 0, cus = 0, per_cu = 0;
        hipGetDevice(&dev);
        hipDeviceGetAttribute(&cus, hipDeviceAttributeMultiprocessorCount, dev);
        hipFuncSetAttribute((const void*)hybrid_fwd, hipFuncAttributeMaxDynamicSharedMemorySize, LDS_BYTES);
        hipOccupancyMaxActiveBlocksPerMultiprocessor(&per_cu, (const void*)hybrid_fwd, 512, LDS_BYTES);
        if (per_cu < 1) per_cu = 1;
        grid_blocks = cus * (per_cu > 1 ? 1 : per_cu);
        if (ws_size < WS_END) fprintf(stderr, "kernel_launch: workspace too small: %zu < %zu\n", ws_size, (size_t)WS_END);
    }
    Params p{};
    for (int i = 0; i < 27; ++i) p.in[i] = (const float*)d_in[i];
    p.out = (float*)d_out; p.ws = (uchar*)d_ws;
    (void)hipMemsetAsync(d_ws, 0, WS_CTL_BYTES, stream);
    void* args[] = {&p};
    hipError_t e = hipLaunchCooperativeKernel((const void*)hybrid_fwd, dim3(grid_blocks), dim3(512), args, LDS_BYTES, stream);
    if (e != hipSuccess) fprintf(stderr, "cooperative launch failed: %s (grid %d)\n", hipGetErrorString(e), grid_blocks);
}
```
